# Optimizing an MI355X kernel written in HIP

```python
import jax, jax.numpy as jnp
from jax import lax
import numpy as np

D_MODEL = 1024
BATCH = 8
SEQ = 4096
DEPTH = 1
DEC_BATCH = 4
DEC_SEQ = 8192
PAST_LEN = 128

MIX_W = D_MODEL
CONV_W = MIX_W // 2
ML_W = MIX_W - CONV_W
ML_HEADS = 4
ML_HEAD_DIM = ML_W // ML_HEADS
ML_CHUNK = 128
CONV_K = 3
IN_COLS = 3 * CONV_W + 4 * ML_W + 4 * ML_HEADS
N_MEM = 256
XA_HEADS = 4
XA_HEAD_DIM = D_MODEL // XA_HEADS
PK_HEADS = 8
PK_DIM = D_MODEL // 4
N_KEYS = 128
N_EXPERTS = N_KEYS * N_KEYS
PK_TOPK = 16
PEER_BLOCK = 128
EPS = 1e-6
M_INIT = -1e30

kernel_name = "hymba_conv_mlstm_peer_encoder"


def _rms(x, w):
    xf = x.astype(jnp.float32)
    y = xf * lax.rsqrt(jnp.mean(xf * xf, axis=-1, keepdims=True) + EPS)
    return (y * w.astype(jnp.float32)).astype(x.dtype)


def _mlstm_dir(q, k, v, ig, fg):
    Bn, H, S, dh = q.shape
    nc = S // ML_CHUNK
    L = ML_CHUNK
    q = q.reshape(Bn, H, nc, L, dh) * (dh ** -0.5)
    k = k.reshape(Bn, H, nc, L, dh)
    v = v.reshape(Bn, H, nc, L, dh)
    ig = ig.reshape(Bn, H, nc, L)
    a = jnp.cumsum(jax.nn.log_sigmoid(fg).reshape(Bn, H, nc, L), axis=-1)
    g = a[..., -1]
    w = g[..., None] - a + ig

    def step(carry, inp):
        C, n, m = carry
        g_c, w_c, k_c, v_c = inp
        m_new = jnp.maximum(g_c + m, jnp.max(w_c, axis=-1))
        decay = jnp.exp(g_c + m - m_new)
        sc = jnp.exp(w_c - m_new[..., None])
        C_new = decay[..., None, None] * C + jnp.einsum('bhl,bhlk,bhlv->bhkv', sc, k_c, v_c)
        n_new = decay[..., None] * n + jnp.einsum('bhl,bhlk->bhk', sc, k_c)
        return (C_new, n_new, m_new), (C, n, m)

    init = (jnp.zeros((Bn, H, dh, dh), jnp.float32),
            jnp.zeros((Bn, H, dh), jnp.float32),
            jnp.full((Bn, H), M_INIT, jnp.float32))
    xs = (jnp.moveaxis(g, 2, 0), jnp.moveaxis(w, 2, 0), jnp.moveaxis(k, 2, 0), jnp.moveaxis(v, 2, 0))
    _, (C_prev, n_prev, m_prev) = lax.scan(step, init, xs)
    C_prev = jnp.moveaxis(C_prev, 0, 2)
    n_prev = jnp.moveaxis(n_prev, 0, 2)
    m_prev = jnp.moveaxis(m_prev, 0, 2)

    causal = jnp.tril(jnp.ones((L, L), bool))
    dlog = jnp.where(causal, a[..., :, None] - a[..., None, :] + ig[..., None, :], -jnp.inf)
    m_inter = a + m_prev[..., None]
    m_t = jnp.maximum(m_inter, jnp.max(dlog, axis=-1))
    s = jnp.exp(dlog - m_t[..., None]) * jnp.einsum('bhctd,bhcsd->bhcts', q, k)
    e_inter = jnp.exp(m_inter - m_t)
    num = (jnp.einsum('bhcts,bhcsd->bhctd', s, v)
           + e_inter[..., None] * jnp.einsum('bhctk,bhckv->bhctv', q, C_prev))
    den = jnp.sum(s, axis=-1) + e_inter * jnp.einsum('bhctk,bhck->bhct', q, n_prev)
    h = num / jnp.maximum(jnp.abs(den), jnp.exp(-m_t))[..., None]
    return h.reshape(Bn, H, S, dh)


def _mixer(h, w_in, gate_b, conv_w, conv_b, ml_norm_w, w_out):
    Bn, S, _ = h.shape
    z = h @ w_in
    c0 = 3 * CONV_W
    idx = [CONV_W, 2 * CONV_W, c0, c0 + ML_W, c0 + 2 * ML_W, c0 + 3 * ML_W, c0 + 4 * ML_W]
    xt, bg, cg, q, k, v, o, gates = jnp.split(z, idx, axis=-1)

    u = cg * xt
    up = jnp.pad(u, ((0, 0), (1, 1), (0, 0)))
    conv = conv_w[0] * up[:, :-2] + conv_w[1] * up[:, 1:-1] + conv_w[2] * up[:, 2:] + conv_b
    y_conv = bg * conv

    def heads(t):
        return t.reshape(Bn, S, ML_HEADS, ML_HEAD_DIM).transpose(0, 2, 1, 3).astype(jnp.float32)
    qh, kh, vh = heads(q), heads(k), heads(v)
    gt = (gates + gate_b).astype(jnp.float32).reshape(Bn, S, 4, ML_HEADS).transpose(2, 0, 3, 1)
    h_fwd = _mlstm_dir(qh, kh, vh, gt[0], gt[2])
    h_bwd = _mlstm_dir(qh[:, :, ::-1], kh[:, :, ::-1], vh[:, :, ::-1],
                       gt[1][:, :, ::-1], gt[3][:, :, ::-1])[:, :, ::-1]
    hm = (h_fwd + h_bwd).transpose(0, 2, 1, 3)
    hm = _rms(hm, ml_norm_w.reshape(ML_HEADS, ML_HEAD_DIM)).reshape(Bn, S, ML_W).astype(h.dtype)
    y_ml = jax.nn.sigmoid(o) * hm

    return jnp.concatenate([y_conv, y_ml], axis=-1) @ w_out


def _cross_attn(h, memn, wq, wk, wv, wo):
    Bn, S, _ = h.shape
    q = (h @ wq).reshape(Bn, S, XA_HEADS, XA_HEAD_DIM)
    k = (memn @ wk).reshape(Bn, -1, XA_HEADS, XA_HEAD_DIM)
    v = (memn @ wv).reshape(Bn, -1, XA_HEADS, XA_HEAD_DIM)
    s = jnp.einsum('bshd,bmhd->bhsm', q, k).astype(jnp.float32) * (XA_HEAD_DIM ** -0.5)
    p = jax.nn.softmax(s, axis=-1).astype(h.dtype)
    o = jnp.einsum('bhsm,bmhd->bshd', p, v).reshape(Bn, S, D_MODEL)
    return o @ wo


def _peer(h, wq, keys1, keys2, u_tab, v_tab):
    Bn, S, _ = h.shape
    T = Bn * S
    ht = h.reshape(T, D_MODEL)
    q = (ht @ wq).reshape(T, PK_HEADS, PK_DIM)
    half = PK_DIM // 2
    s1 = jnp.einsum('thd,hnd->thn', q[..., :half], keys1)
    s2 = jnp.einsum('thd,hnd->thn', q[..., half:], keys2)
    v1, i1 = lax.top_k(s1, PK_TOPK)
    v2, i2 = lax.top_k(s2, PK_TOPK)
    cand = (v1[..., :, None] + v2[..., None, :]).reshape(T, PK_HEADS, PK_TOPK * PK_TOPK)
    cidx = (i1[..., :, None] * N_KEYS + i2[..., None, :]).reshape(T, PK_HEADS, PK_TOPK * PK_TOPK)
    sc, pos = lax.top_k(cand, PK_TOPK)
    eidx = jnp.take_along_axis(cidx, pos, axis=-1)
    gate = jax.nn.softmax(sc.astype(jnp.float32), axis=-1).astype(h.dtype)

    nb = T // PEER_BLOCK

    def block(args):
        xb, ib, gb = args
        ue = jnp.take(u_tab, ib, axis=0)
        ve = jnp.take(v_tab, ib, axis=0)
        act = jax.nn.gelu(jnp.einsum('td,thkd->thk', xb, ue))
        return jnp.einsum('thk,thkd->td', gb * act, ve)

    out = lax.map(block, (ht.reshape(nb, PEER_BLOCK, D_MODEL),
                          eidx.reshape(nb, PEER_BLOCK, PK_HEADS, PK_TOPK),
                          gate.reshape(nb, PEER_BLOCK, PK_HEADS, PK_TOPK)))
    return out.reshape(Bn, S, D_MODEL)


def _trunk(x, mem, norm_mix_w, w_in, gate_b, conv_w, conv_b, mlstm_norm_w, w_out,
           norm_xattn_w, norm_mem_w, xa_wq, xa_wk, xa_wv, xa_wo,
           norm_ffn_w, peer_wq, peer_keys1, peer_keys2, peer_u, peer_v, norm_final_w):
    for l in range(DEPTH):
        x = x + _mixer(_rms(x, norm_mix_w[l]), w_in[l], gate_b[l], conv_w[l], conv_b[l],
                       mlstm_norm_w[l], w_out[l])
        x = x + _cross_attn(_rms(x, norm_xattn_w[l]), _rms(mem, norm_mem_w[l]),
                            xa_wq[l], xa_wk[l], xa_wv[l], xa_wo[l])
        x = x + _peer(_rms(x, norm_ffn_w[l]), peer_wq[l], peer_keys1[l], peer_keys2[l],
                      peer_u[l], peer_v[l])
    return _rms(x, norm_final_w)


def setup_inputs(seed: int = 0) -> dict:
    key = jax.random.key(seed)
    ks = jax.random.split(key, 28)
    f32 = jnp.float32
    L = DEPTH

    def nrm(k, shape, scale):
        return jax.random.normal(k, shape, f32) * scale

    def gain(k, shape):
        return 1.0 + 0.02 * jax.random.normal(k, shape, f32)

    i_bias = nrm(ks[6], (L, 2 * ML_HEADS), 0.1)
    f_base = jnp.tile(jnp.linspace(3.0, 6.0, ML_HEADS, dtype=f32), 2)
    f_bias = f_base[None, :] + nrm(ks[7], (L, 2 * ML_HEADS), 0.1)
    return {
        "x_prompt": nrm(ks[0], (BATCH, SEQ, D_MODEL), 1.0),
        "x_sample": nrm(ks[1], (DEC_BATCH, DEC_SEQ, D_MODEL), 1.0),
        "mem_prompt": nrm(ks[2], (BATCH, N_MEM, D_MODEL), 1.0),
        "mem_sample": nrm(ks[3], (DEC_BATCH, N_MEM, D_MODEL), 1.0),
        "norm_mix_w": gain(ks[4], (L, D_MODEL)),
        "w_in": nrm(ks[5], (L, D_MODEL, IN_COLS), D_MODEL ** -0.5),
        "gate_b": jnp.concatenate([i_bias, f_bias], axis=-1),
        "conv_w": nrm(ks[8], (L, CONV_K, CONV_W), CONV_K ** -0.5),
        "conv_b": nrm(ks[9], (L, CONV_W), 0.02),
        "mlstm_norm_w": gain(ks[10], (L, ML_W)),
        "w_out": nrm(ks[11], (L, MIX_W, D_MODEL), MIX_W ** -0.5),
        "norm_xattn_w": gain(ks[12], (L, D_MODEL)),
        "norm_mem_w": gain(ks[13], (L, D_MODEL)),
        "xa_wq": nrm(ks[14], (L, D_MODEL, D_MODEL), D_MODEL ** -0.5),
        "xa_wk": nrm(ks[15], (L, D_MODEL, D_MODEL), D_MODEL ** -0.5),
        "xa_wv": nrm(ks[16], (L, D_MODEL, D_MODEL), D_MODEL ** -0.5),
        "xa_wo": nrm(ks[17], (L, D_MODEL, D_MODEL), D_MODEL ** -0.5),
        "norm_ffn_w": gain(ks[18], (L, D_MODEL)),
        "peer_wq": nrm(ks[19], (L, D_MODEL, PK_HEADS * PK_DIM), D_MODEL ** -0.5),
        "peer_keys1": nrm(ks[20], (L, PK_HEADS, N_KEYS, PK_DIM // 2), (PK_DIM // 2) ** -0.5),
        "peer_keys2": nrm(ks[21], (L, PK_HEADS, N_KEYS, PK_DIM // 2), (PK_DIM // 2) ** -0.5),
        "peer_u": nrm(ks[22], (L, N_EXPERTS, D_MODEL), D_MODEL ** -0.5),
        "peer_v": nrm(ks[23], (L, N_EXPERTS, D_MODEL), (PK_HEADS * PK_TOPK) ** -0.5),
        "norm_final_w": gain(ks[24], (D_MODEL,)),
    }


def reference(x_prompt, x_sample, mem_prompt, mem_sample, norm_mix_w, w_in, gate_b, conv_w, conv_b,
              mlstm_norm_w, w_out, norm_xattn_w, norm_mem_w, xa_wq, xa_wk, xa_wv, xa_wo,
              norm_ffn_w, peer_wq, peer_keys1, peer_keys2, peer_u, peer_v, norm_final_w):
    params = (norm_mix_w, w_in, gate_b, conv_w, conv_b, mlstm_norm_w, w_out,
              norm_xattn_w, norm_mem_w, xa_wq, xa_wk, xa_wv, xa_wo,
              norm_ffn_w, peer_wq, peer_keys1, peer_keys2, peer_u, peer_v, norm_final_w)
    y_prompt = _trunk(x_prompt, mem_prompt, *params)
    y_sample = _trunk(x_sample, mem_sample, *params)
    return (y_prompt, y_sample)
```

```cpp
#include <hip/hip_runtime.h>
#include <hip/hip_cooperative_groups.h>
#include <cstdio>
namespace cg = cooperative_groups;

#ifndef STAGE
#define STAGE 4
#endif
#ifndef PROBE
#define PROBE 0
#endif
#ifndef USE_XCD_BAR
#define USE_XCD_BAR 1
#endif
#ifndef USE_COOP
#define USE_COOP 1
#endif

#define DEVI __device__ __forceinline__
typedef unsigned short us;
typedef unsigned int u32;
using bf16x8 = __attribute__((ext_vector_type(8))) short;
using f32x4  = __attribute__((ext_vector_type(4))) float;

constexpr int TG = 32768;
constexpr int ZW = 3584;
constexpr int NIN_PAD = 3712;
constexpr float EPS = 1e-6f;
constexpr int LDS_BYTES = 151552;
constexpr int NT = 512;
constexpr float QS = 0.08838834764831845f;

struct Params {
  const float *x_prompt, *x_sample, *mem_prompt, *mem_sample, *norm_mix_w, *w_in, *gate_b, *conv_w, *conv_b,
      *mlstm_norm_w, *w_out, *norm_xattn_w, *norm_mem_w, *xa_wq, *xa_wk, *xa_wv, *xa_wo, *norm_ffn_w, *peer_wq,
      *peer_keys1, *peer_keys2, *peer_u, *peer_v, *norm_final_w;
  float* out;
  us *Wt_in, *Wt_out, *Wt_q, *Wt_k, *Wt_v, *Wt_o, *Wt_pq, *keys1b, *keys2b, *Ub, *Vb, *memn, *Kmem, *VmemT;
  float *ss1, *ss2;
  us* z; float* gates; us* states; float *nstate, *scstate, *nprev, *mprev; us* buf67;
  us *xb, *Qb, *Ob, *pq; int* eidx; float* gatew;
  unsigned* bar;
};

DEVI int opq(int x) { asm volatile("" : "+v"(x)); return x; }
DEVI us f2bf(float f) { u32 u = __float_as_uint(f); u += 0x7fffu + ((u >> 16) & 1u); return (us)(u >> 16); }
DEVI float bf2f(us h) { return __uint_as_float(((u32)h) << 16); }
DEVI u32 pack2(float a, float b) { return (u32)f2bf(a) | ((u32)f2bf(b) << 16); }
DEVI float bflo(u32 w) { return __uint_as_float(w << 16); }
DEVI float bfhi(u32 w) { return __uint_as_float(w & 0xffff0000u); }
DEVI float wave_sum(float v) {
#pragma unroll
  for (int o = 32; o >= 1; o >>= 1) v += __shfl_xor(v, o);
  return v;
}
DEVI float sigmoidf_(float x) { return 1.f / (1.f + __expf(-x)); }
DEVI float logsigf_(float x) { return fminf(x, 0.f) - log1pf(__expf(-fabsf(x))); }
DEVI float gelu_tanh(float x) {
  float y = 0.7978845608028654f * (x + 0.044715f * x * x * x);
  float t = 1.f - 2.f / (__expf(2.f * y) + 1.f);
  return 0.5f * x * (1.f + t);
}
using i64x2 = __attribute__((ext_vector_type(2))) long;
DEVI u32 pack4_fp8(float a, float b, float c, float d) {
  int r = 0;
  r = __builtin_amdgcn_cvt_pk_fp8_f32(a, b, r, false);
  r = __builtin_amdgcn_cvt_pk_fp8_f32(c, d, r, true);
  return (u32)r;
}
DEVI u32 ordf(float f) { u32 u = __float_as_uint(f); return u ^ ((u >> 31) ? 0xFFFFFFFFu : 0x80000000u); }
DEVI float unordf(u32 o) { u32 u = (o & 0x80000000u) ? (o ^ 0x80000000u) : ~o; return __uint_as_float(u); }

#define WAIT_V0() asm volatile("s_waitcnt vmcnt(0)" ::: "memory")
template <int BM, int BN, int WM, int WN, bool ALDS, bool PRE = false>
DEVI void gemm_core(const us* A, int lda, const us* __restrict__ Bt, int ldb, int K, char* stage,
                    f32x4 (&acc)[BM / 16 / WM][BN / 16 / WN]) {
  constexpr int MI = BM / 16 / WM, NI = BN / 16 / WN;
  constexpr int ABYTES = ALDS ? 0 : BM * 128;
  constexpr int SBYTES = ABYTES + BN * 128;
  const int tid = opq(threadIdx.x), lane = tid & 63, wid = tid >> 6;
  const int wr = wid / WN, wc = wid % WN;
  const int fr = lane & 15, fq = lane >> 4;
  const int sw = (fq ^ ((fr >> 2) & 3)) << 4;
  auto issue = [&](int buf, int k0) {
    char* SA = stage + buf * SBYTES;
    char* SB = SA + ABYTES;
    if (!ALDS) {
#pragma unroll
      for (int i = 0; i < BM / 64; ++i) {
        int c = tid + i * 512;
        int kh = c / (BM * 4), cc = c % (BM * 4);
        int r = cc >> 2;
        int ch = (cc & 3) ^ ((r >> 2) & 3);
        __builtin_amdgcn_global_load_lds((const u32*)(A + (size_t)r * lda + k0 + kh * 32 + ch * 8), (u32*)(SA + c * 16), 16, 0, 0);
      }
    }
#pragma unroll
    for (int i = 0; i < BN / 64; ++i) {
      int c = tid + i * 512;
      int kh = c / (BN * 4), cc = c % (BN * 4);
      int r = cc >> 2;
      int ch = (cc & 3) ^ ((r >> 2) & 3);
      __builtin_amdgcn_global_load_lds((const u32*)(Bt + (size_t)r * ldb + k0 + kh * 32 + ch * 8), (u32*)(SB + c * 16), 16, 0, 0);
    }
  };
  const int nt = K >> 6;
  if (!PRE) issue(0, 0);
  WAIT_V0();
  __syncthreads();
#pragma unroll 1
  for (int t = 0; t < nt; ++t) {
    const int cur = t & 1;
    if (t + 1 < nt) issue(cur ^ 1, (t + 1) * 64);
    const char* SA = stage + cur * SBYTES;
    const char* SB = SA + ABYTES;
#pragma unroll
    for (int kh = 0; kh < 2; ++kh) {
      bf16x8 a[MI], b[NI];
#pragma unroll
      for (int m = 0; m < MI; ++m) {
        if (ALDS) a[m] = *(const bf16x8*)(A + (wr * (MI * 16) + m * 16 + fr) * lda + t * 64 + kh * 32 + fq * 8);
        else a[m] = *(const bf16x8*)(SA + kh * (BM * 64) + (wr * (MI * 16) + m * 16 + fr) * 64 + sw);
      }
#pragma unroll
      for (int n = 0; n < NI; ++n) b[n] = *(const bf16x8*)(SB + kh * (BN * 64) + (wc * (NI * 16) + n * 16 + fr) * 64 + sw);
      __builtin_amdgcn_sched_barrier(0);
#pragma unroll
      for (int m = 0; m < MI; ++m)
#pragma unroll
        for (int n = 0; n < NI; ++n) acc[m][n] = __builtin_amdgcn_mfma_f32_16x16x32_bf16(b[n], a[m], acc[m][n], 0, 0, 0);
      __builtin_amdgcn_sched_barrier(0);
    }
    WAIT_V0();
    __syncthreads();
  }
}


template <int BM, int BN, bool ALDS>
DEVI void gemm_issue0(const us* A, int lda, const us* __restrict__ Bt, int ldb, char* stage) {
  constexpr int ABYTES = ALDS ? 0 : BM * 128;
  const int tid = opq(threadIdx.x);
  if (!ALDS) {
#pragma unroll
    for (int i = 0; i < BM / 64; ++i) {
      int c = tid + i * 512;
      int kh = c / (BM * 4), cc = c % (BM * 4);
      int r = cc >> 2;
      int ch = (cc & 3) ^ ((r >> 2) & 3);
      __builtin_amdgcn_global_load_lds((const u32*)(A + (size_t)r * lda + kh * 32 + ch * 8), (u32*)(stage + c * 16), 16, 0, 0);
    }
  }
#pragma unroll
  for (int i = 0; i < BN / 64; ++i) {
    int c = tid + i * 512;
    int kh = c / (BN * 4), cc = c % (BN * 4);
    int r = cc >> 2;
    int ch = (cc & 3) ^ ((r >> 2) & 3);
    __builtin_amdgcn_global_load_lds((const u32*)(Bt + (size_t)r * ldb + kh * 32 + ch * 8), (u32*)(stage + ABYTES + c * 16), 16, 0, 0);
  }
}

namespace g8 {
#define G8_LAS __attribute__((address_space(3)))
constexpr int BM = 256, BK = 64, HALF = 128, HTB = HALF * BK * 2, NXCD = 8, WGM = 8;
DEVI int lds_byte(int r, int c) { const int st = (r >> 4) * 2 + (c >> 5), rr = r & 15, cc = c & 31, ob = rr * 64 + cc * 2; return st * 1024 + (ob ^ (((ob >> 9) & 1) << 5)); }
DEVI void stage_rc(int b, int& R, int& C) { const int st = b / 1024, sb = b % 1024, swz = sb ^ (((sb >> 9) & 1) << 5); R = (st >> 1) * 16 + swz / 64; C = (st & 1) * 32 + (swz % 64) / 2; }
DEVI int perm32(int rho) { const int n = rho >> 4, i = rho & 15; return 8 * (i >> 2) + 4 * n + (i & 3); }
struct Unit { int pm, pn; };
struct Order {
  int nM, nN, nwg, G, c;
  DEVI void init(int M, int N, int G_, int c_) { nM = M / BM; nN = N / BM; nwg = nM * nN; G = G_; c = c_; }
  DEVI bool next(int i, Unit& u) const {
    const long L = (long)i * G + c; if (L >= nwg) return false;
    int wgid = (int)L; { const int q = nwg / NXCD, r = nwg % NXCD, xcd = wgid % NXCD, off = wgid / NXCD; wgid = (xcd < r ? xcd * (q + 1) : r * (q + 1) + (xcd - r) * q) + off; }
    const int nig = WGM * nN, gid = wgid / nig, fm = gid * WGM, gsz = (nM - fm) < WGM ? (nM - fm) : WGM;
    u.pm = fm + ((wgid % nig) % gsz); u.pn = (wgid % nig) / gsz; return true;
  }
};
DEVI u32 cvt_pk_bf16(float lo, float hi) { u32 r; asm volatile("v_cvt_pk_bf16_f32 %0, %1, %2" : "=v"(r) : "v"(lo), "v"(hi)); return r; }

template <class Epi>
DEVI void gemm_phase(G8_LAS unsigned char* lds, const us* Ag, int lda, const us* Btg, int M, int N, int K, const Epi& E) {
  const int tid = opq(threadIdx.x), wid = __builtin_amdgcn_readfirstlane(tid >> 6), lane = tid & 63, wr = wid >> 2, wc = wid & 3, fr = lane & 15, fq = lane >> 4;
  const int nt = K / BK;
  Order S; S.init(M, N, gridDim.x, blockIdx.x);
  unsigned voffA[2], voffB[2];
#pragma unroll
  for (int i = 0; i < 2; ++i) { int R, C; stage_rc(tid * 16 + i * 8192, R, C); const int Rb = (R & ~31) + perm32(R & 31);
    voffA[i] = (unsigned)(R * lda + C) * 2u; voffB[i] = (unsigned)(Rb * K + C) * 2u; }
  const size_t kstep = (size_t)(BK * 2);
  const size_t hstep = (size_t)HALF * K * 2, hstepA = (size_t)HALF * lda * 2;
  const size_t tstep = 2 * hstep, tstepA = 2 * hstepA;
  const unsigned ldsw = (unsigned)wid * 1024u;
  const int aoff = lds_byte(wr * 64 + fr, fq * 8), boff = lds_byte(wc * 32 + fr, fq * 8);
#define G8_SA(b, h) (((b) * 2 + (h)) * HTB)
#define G8_SB(b, h) ((4 + (b) * 2 + (h)) * HTB)
#define G8_STAGE(bufoff, gbase, voff) do { _Pragma("unroll") for (int _i = 0; _i < 2; ++_i) \
    __builtin_amdgcn_global_load_lds((const unsigned*)((const char*)(gbase) + (voff)[_i]), (G8_LAS unsigned*)(lds + (bufoff) + ldsw + _i * 8192), 16, 0, 0); } while (0)
#define G8_LDA(dst, b, h) do { _Pragma("unroll") for (int m = 0; m < 4; ++m) _Pragma("unroll") for (int k = 0; k < 2; ++k) dst[m][k] = *(const G8_LAS bf16x8*)(lds + G8_SA(b, h) + aoff + m * 2048 + k * 1024); } while (0)
#define G8_LDB(dst, b, h) do { _Pragma("unroll") for (int n = 0; n < 2; ++n) _Pragma("unroll") for (int k = 0; k < 2; ++k) dst[n][k] = *(const G8_LAS bf16x8*)(lds + G8_SB(b, h) + boff + n * 2048 + k * 1024); } while (0)
#define G8_MMA(ai, bj, At, Bt) do { __builtin_amdgcn_s_setprio(1); _Pragma("unroll") for (int m = 0; m < 4; ++m) _Pragma("unroll") for (int n = 0; n < 2; ++n) _Pragma("unroll") for (int k = 0; k < 2; ++k) \
    acc[ai][bj][m][n] = __builtin_amdgcn_mfma_f32_16x16x32_bf16(Bt[n][k], At[m][k], acc[ai][bj][m][n], 0, 0, 0); __builtin_amdgcn_s_setprio(0); } while (0)
#define G8_WAIT_V(n) asm volatile("s_waitcnt vmcnt(" #n ")" ::: "memory")
#define G8_WAIT_L(n) asm volatile("s_waitcnt lgkmcnt(" #n ")" ::: "memory")
#define G8_BAR __builtin_amdgcn_s_barrier()
#define G8_SCHED __builtin_amdgcn_sched_barrier(0)
  Unit cur, nxt; int ui = 0;
  if (!S.next(0, cur)) return;
  f32x4 acc[2][2][4][2];
#pragma unroll
  for (int a = 0; a < 2; ++a)
#pragma unroll
    for (int b = 0; b < 2; ++b)
#pragma unroll
      for (int m = 0; m < 4; ++m)
#pragma unroll
        for (int n = 0; n < 2; ++n) acc[a][b][m][n] = (f32x4){0.f, 0.f, 0.f, 0.f};
  bf16x8 At[4][2], B0[2][2], B1[2][2];
  const char* cA = (const char*)Ag + (size_t)cur.pm * tstepA; const char* cB = (const char*)Btg + (size_t)cur.pn * tstep;
  G8_WAIT_V(0); G8_WAIT_L(0); G8_BAR;
  G8_STAGE(G8_SB(0, 0), cB, voffB); G8_STAGE(G8_SA(0, 0), cA, voffA); G8_STAGE(G8_SB(0, 1), cB + hstep, voffB); G8_STAGE(G8_SA(0, 1), cA + hstepA, voffA);
  if (wr == 1) G8_BAR;
  G8_WAIT_V(4); G8_BAR;
  G8_STAGE(G8_SB(1, 0), cB + kstep, voffB); G8_STAGE(G8_SA(1, 0), cA + kstep, voffA); G8_STAGE(G8_SB(1, 1), cB + hstep + kstep, voffB);
  G8_WAIT_V(6); G8_BAR;
  for (;;) {
    const bool has_next = S.next(ui + 1, nxt);
    const char* nA = has_next ? (const char*)Ag + (size_t)nxt.pm * tstepA : cA; const char* nB = has_next ? (const char*)Btg + (size_t)nxt.pn * tstep : cB;
    for (int t = 0; t < nt; t += 2) {
      const bool last = (t == nt - 2);
      const char* a1 = cA + (size_t)(t + 1) * kstep;
      const char* a2 = last ? nA : cA + (size_t)(t + 2) * kstep; const char* b2 = last ? nB : cB + (size_t)(t + 2) * kstep;
      const char* a3 = a2 + kstep; const char* b3 = b2 + kstep;
      G8_LDB(B0, 0, 0); G8_SCHED; G8_LDA(At, 0, 0); G8_STAGE(G8_SA(1, 1), a1 + hstepA, voffA);
      G8_WAIT_L(8); G8_BAR; G8_WAIT_L(0); G8_MMA(0, 0, At, B0); G8_BAR; G8_SCHED;
      G8_LDB(B1, 0, 1); G8_STAGE(G8_SB(0, 0), b2, voffB);
      G8_BAR; G8_WAIT_L(0); G8_MMA(0, 1, At, B1); G8_BAR;
      G8_LDA(At, 0, 1); G8_STAGE(G8_SA(0, 0), a2, voffA);
      G8_BAR; G8_WAIT_L(0); G8_MMA(1, 0, At, B0); G8_BAR; G8_SCHED;
      G8_STAGE(G8_SB(0, 1), b2 + hstep, voffB);
      G8_WAIT_V(6); G8_BAR; G8_MMA(1, 1, At, B1); G8_BAR;
      G8_LDB(B0, 1, 0); G8_SCHED; G8_LDA(At, 1, 0); G8_STAGE(G8_SA(0, 1), a2 + hstepA, voffA);
      G8_WAIT_L(8); G8_BAR; G8_WAIT_L(0); G8_MMA(0, 0, At, B0); G8_BAR; G8_SCHED;
      G8_LDB(B1, 1, 1); G8_STAGE(G8_SB(1, 0), b3, voffB);
      G8_BAR; G8_WAIT_L(0); G8_MMA(0, 1, At, B1); G8_BAR;
      G8_LDA(At, 1, 1); G8_STAGE(G8_SA(1, 0), a3, voffA);
      G8_BAR; G8_WAIT_L(0); G8_MMA(1, 0, At, B0); G8_BAR; G8_SCHED;
      G8_STAGE(G8_SB(1, 1), b3 + hstep, voffB);
      G8_WAIT_V(6); G8_BAR; G8_MMA(1, 1, At, B1); G8_BAR;
    }
    E(acc, cur, wr, wc, fr, fq);
    if (!has_next) break;
#pragma unroll
    for (int a = 0; a < 2; ++a)
#pragma unroll
      for (int b = 0; b < 2; ++b)
#pragma unroll
        for (int m = 0; m < 4; ++m)
#pragma unroll
          for (int n = 0; n < 2; ++n) acc[a][b][m][n] = (f32x4){0.f, 0.f, 0.f, 0.f};
    cur = nxt; cA = nA; cB = nB; ++ui;
  }
  G8_WAIT_V(0);
  if (wr == 0) G8_BAR;
  G8_BAR;
#undef G8_SA
#undef G8_SB
#undef G8_STAGE
#undef G8_LDA
#undef G8_LDB
#undef G8_MMA
#undef G8_WAIT_V
#undef G8_WAIT_L
#undef G8_BAR
#undef G8_SCHED
}

struct EpiStoreBf16 {
  us* O; int ldc;
  DEVI void operator()(const f32x4 (&acc)[2][2][4][2], const Unit& u, int wr, int wc, int fr, int fq) const {
    const int row0 = u.pm * BM + wr * 64 + fr, col0 = u.pn * BM + wc * 32 + 8 * fq;
#pragma unroll
    for (int ai = 0; ai < 2; ++ai)
#pragma unroll
      for (int m = 0; m < 4; ++m) {
        us* rowp = O + (size_t)(row0 + ai * HALF + m * 16) * ldc + col0;
#pragma unroll
        for (int bj = 0; bj < 2; ++bj) {
          const f32x4 v0 = acc[ai][bj][m][0], v1 = acc[ai][bj][m][1];
          *(uint4*)(rowp + bj * HALF) = make_uint4(cvt_pk_bf16(v0[0], v0[1]), cvt_pk_bf16(v0[2], v0[3]), cvt_pk_bf16(v1[0], v1[1]), cvt_pk_bf16(v1[2], v1[3]));
        }
      }
  }
};

template <bool XF32>
struct EpiResid {
  const float* xf; const us* xb; us* xout; int ldo; float* ss;
  DEVI void operator()(const f32x4 (&acc)[2][2][4][2], const Unit& u, int wr, int wc, int fr, int fq) const {
    const int row0 = u.pm * BM + wr * 64 + fr, col0 = u.pn * BM + wc * 32 + 8 * fq;
#pragma unroll
    for (int ai = 0; ai < 2; ++ai)
#pragma unroll
      for (int m = 0; m < 4; ++m) {
        const int row = row0 + ai * HALF + m * 16;
        float rsum = 0.f;
#pragma unroll
        for (int bj = 0; bj < 2; ++bj) {
          const int col = col0 + bj * HALF;
          float xo[8];
          if (XF32) {
            const float4 a = *(const float4*)(xf + (size_t)row * 1024 + col), b = *(const float4*)(xf + (size_t)row * 1024 + col + 4);
            xo[0] = a.x; xo[1] = a.y; xo[2] = a.z; xo[3] = a.w; xo[4] = b.x; xo[5] = b.y; xo[6] = b.z; xo[7] = b.w;
          } else {
            const uint4 a = *(const uint4*)(xb + (size_t)row * 1024 + col);
            xo[0] = bflo(a.x); xo[1] = bfhi(a.x); xo[2] = bflo(a.y); xo[3] = bfhi(a.y); xo[4] = bflo(a.z); xo[5] = bfhi(a.z); xo[6] = bflo(a.w); xo[7] = bfhi(a.w);
          }
          const f32x4 v0 = acc[ai][bj][m][0], v1 = acc[ai][bj][m][1];
          float xn[8] = {xo[0] + v0[0], xo[1] + v0[1], xo[2] + v0[2], xo[3] + v0[3], xo[4] + v1[0], xo[5] + v1[1], xo[6] + v1[2], xo[7] + v1[3]};
          *(uint4*)(xout + (size_t)row * ldo + col) = make_uint4(cvt_pk_bf16(xn[0], xn[1]), cvt_pk_bf16(xn[2], xn[3]), cvt_pk_bf16(xn[4], xn[5]), cvt_pk_bf16(xn[6], xn[7]));
#pragma unroll
          for (int e = 0; e < 8; ++e) rsum += xn[e] * xn[e];
        }
        rsum += __shfl_xor(rsum, 16); rsum += __shfl_xor(rsum, 32);
        if (fq == 0) atomicAdd(ss + row, rsum);
      }
  }
};

struct EpiScaleBf16 {
  us* O; int ldc; const float* ss;
  DEVI void operator()(const f32x4 (&acc)[2][2][4][2], const Unit& u, int wr, int wc, int fr, int fq) const {
    const int row0 = u.pm * BM + wr * 64 + fr, col0 = u.pn * BM + wc * 32 + 8 * fq;
#pragma unroll
    for (int ai = 0; ai < 2; ++ai)
#pragma unroll
      for (int m = 0; m < 4; ++m) {
        const int row = row0 + ai * HALF + m * 16;
        const float rs = rsqrtf(ss[row] * (1.f / 1024.f) + EPS);
        us* rowp = O + (size_t)row * ldc + col0;
#pragma unroll
        for (int bj = 0; bj < 2; ++bj) {
          const f32x4 v0 = acc[ai][bj][m][0] * rs, v1 = acc[ai][bj][m][1] * rs;
          *(uint4*)(rowp + bj * HALF) = make_uint4(cvt_pk_bf16(v0[0], v0[1]), cvt_pk_bf16(v0[2], v0[3]), cvt_pk_bf16(v1[0], v1[1]), cvt_pk_bf16(v1[2], v1[3]));
        }
      }
  }
};
}

template <int BM, int WM, int WN>
DEVI void mma_lds(const us* sA, int lda, const us* sB, int ldb, int K, f32x4 (&acc)[BM / 16 / WM][8 / WN]) {
  constexpr int MI = BM / 16 / WM, NI = 8 / WN;
  const int tid = opq(threadIdx.x), lane = tid & 63, wid = tid >> 6;
  const int wr = wid / WN, wc = wid % WN;
  const int fr = lane & 15, fq = lane >> 4;
#pragma unroll 1
  for (int k0 = 0; k0 < K; k0 += 32) {
    bf16x8 a[MI], b[NI];
#pragma unroll
    for (int m = 0; m < MI; ++m) a[m] = *(const bf16x8*)(sA + (wr * (MI * 16) + m * 16 + fr) * lda + k0 + fq * 8);
#pragma unroll
    for (int n = 0; n < NI; ++n) b[n] = *(const bf16x8*)(sB + (wc * (NI * 16) + n * 16 + fr) * ldb + k0 + fq * 8);
#pragma unroll
    for (int m = 0; m < MI; ++m)
#pragma unroll
      for (int n = 0; n < NI; ++n) acc[m][n] = __builtin_amdgcn_mfma_f32_16x16x32_bf16(b[n], a[m], acc[m][n], 0, 0, 0);
  }
}

template <int MI, int NI>
DEVI void zero_acc(f32x4 (&acc)[MI][NI]) {
#pragma unroll
  for (int m = 0; m < MI; ++m)
#pragma unroll
    for (int n = 0; n < NI; ++n) acc[m][n] = f32x4{0.f, 0.f, 0.f, 0.f};
}

DEVI void transpose_w(const float* __restrict__ W, int K, int N, us* __restrict__ Wt, int Npad,
                      const float* __restrict__ rs, int gtid, int gsz) {
  int items = Npad * (K / 8);
  for (int it = gtid; it < items; it += gsz) {
    int n = it % Npad, k8 = it / Npad;
    u32 o[4];
#pragma unroll
    for (int i = 0; i < 4; ++i) {
      int k = k8 * 8 + 2 * i;
      float a = 0.f, b = 0.f;
      if (n < N) {
        a = W[(size_t)k * N + n];
        b = W[(size_t)(k + 1) * N + n];
        if (rs) { a *= rs[k]; b *= rs[k + 1]; }
      }
      o[i] = pack2(a, b);
    }
    *(uint4*)(Wt + (size_t)n * K + k8 * 8) = make_uint4(o[0], o[1], o[2], o[3]);
  }
}

DEVI void cvt_bf16(const float* __restrict__ src, us* __restrict__ dst, size_t n8, int gtid, int gsz) {
  for (size_t i = gtid; i < n8; i += gsz) {
    float4 a = ((const float4*)src)[2 * i], b = ((const float4*)src)[2 * i + 1];
    ((uint4*)dst)[i] = make_uint4(pack2(a.x, a.y), pack2(a.z, a.w), pack2(b.x, b.y), pack2(b.z, b.w));
  }
}

DEVI void cvt_fp8(const float* __restrict__ src, unsigned char* __restrict__ dst, size_t n16, float scale, int gtid, int gsz) {
  for (size_t i = gtid; i < n16; i += gsz) {
    float4 a = ((const float4*)src)[4 * i], b = ((const float4*)src)[4 * i + 1], c = ((const float4*)src)[4 * i + 2], d = ((const float4*)src)[4 * i + 3];
    ((uint4*)dst)[i] = make_uint4(pack4_fp8(a.x * scale, a.y * scale, a.z * scale, a.w * scale), pack4_fp8(b.x * scale, b.y * scale, b.z * scale, b.w * scale),
                                  pack4_fp8(c.x * scale, c.y * scale, c.z * scale, c.w * scale), pack4_fp8(d.x * scale, d.y * scale, d.z * scale, d.w * scale));
  }
}


typedef int v6i __attribute__((ext_vector_type(6)));
typedef int v8i __attribute__((ext_vector_type(8)));
typedef float v32f __attribute__((ext_vector_type(32)));
typedef float v2f __attribute__((ext_vector_type(2)));
typedef __bf16 v32bf __attribute__((ext_vector_type(32)));
typedef short v32s __attribute__((ext_vector_type(32)));
DEVI u32 fp6_code(float x) {
  float a = fminf(fabsf(x), 7.5f);
  float c;
  if (a < 2.f) c = rintf(a * 8.f);
  else if (a < 4.f) c = 16.f + rintf((a - 2.f) * 4.f);
  else c = 24.f + rintf((a - 4.f) * 2.f);
  u32 ci = (u32)c;
  ci = ci > 31u ? 31u : ci;
  return ci | ((x < 0.f) ? 32u : 0u);
}
DEVI void cvt_fp6(const float* __restrict__ src, unsigned char* __restrict__ dst, size_t n32, float scale, int gtid, int gsz) {
  for (size_t i = gtid; i < n32; i += gsz) {
    const float4* sp = (const float4*)(src + i * 32);
    u32 out[6];
    unsigned long long accb = 0ull;
    int nb = 0, k = 0;
#pragma unroll
    for (int j = 0; j < 8; ++j) {
      float4 f = sp[j];
      float e[4] = {f.x, f.y, f.z, f.w};
#pragma unroll
      for (int t = 0; t < 4; ++t) {
        accb |= (unsigned long long)fp6_code(e[t] * scale) << nb;
        nb += 6;
        if (nb >= 32) { out[k++] = (u32)accb; accb >>= 32; nb -= 32; }
      }
    }
    uint2* dp = (uint2*)(dst + i * 24);
    dp[0] = make_uint2(out[0], out[1]); dp[1] = make_uint2(out[2], out[3]); dp[2] = make_uint2(out[4], out[5]);
  }
}


DEVI u32 fp4_code(float x) {
  const float a = fabsf(x);
  u32 c = (a < 0.25f) ? 0u : (a < 0.75f) ? 1u : (a < 1.25f) ? 2u : (a < 1.75f) ? 3u : (a < 2.5f) ? 4u : (a < 3.5f) ? 5u : (a < 5.f) ? 6u : 7u;
  return c | ((x < 0.f) ? 8u : 0u);
}
DEVI void cvt_fp4(const float* __restrict__ src, unsigned char* __restrict__ dst, size_t n32, float scale, int gtid, int gsz) {
  for (size_t i = gtid; i < n32; i += gsz) {
    const float4* sp = (const float4*)(src + i * 32);
    u32 out[4];
#pragma unroll
    for (int d = 0; d < 4; ++d) {
      float4 f0 = sp[2 * d], f1 = sp[2 * d + 1];
      out[d] = fp4_code(f0.x * scale) | (fp4_code(f0.y * scale) << 4) | (fp4_code(f0.z * scale) << 8) | (fp4_code(f0.w * scale) << 12) |
               (fp4_code(f1.x * scale) << 16) | (fp4_code(f1.y * scale) << 20) | (fp4_code(f1.z * scale) << 24) | (fp4_code(f1.w * scale) << 28);
    }
    ((uint4*)dst)[i] = make_uint4(out[0], out[1], out[2], out[3]);
  }
}

DEVI void rms_row_bf16(const float* __restrict__ xrow, const float* __restrict__ w, us* __restrict__ orow, int lane) {
  float4 v[4];
  float ss = 0.f;
#pragma unroll
  for (int i = 0; i < 4; ++i) {
    v[i] = ((const float4*)xrow)[i * 64 + lane];
    ss += v[i].x * v[i].x + v[i].y * v[i].y + v[i].z * v[i].z + v[i].w * v[i].w;
  }
  ss = wave_sum(ss);
  float rs = rsqrtf(ss * (1.f / 1024.f) + EPS);
#pragma unroll
  for (int i = 0; i < 4; ++i) {
    float4 ww = ((const float4*)w)[i * 64 + lane];
    ((uint2*)orow)[i * 64 + lane] = make_uint2(pack2(v[i].x * rs * ww.x, v[i].y * rs * ww.y), pack2(v[i].z * rs * ww.z, v[i].w * rs * ww.w));
  }
}

DEVI void phase_prep(const Params& p) {
  const int gtid = blockIdx.x * NT + opq(threadIdx.x), gsz = gridDim.x * NT;
  transpose_w(p.w_in, 1024, 3600, p.Wt_in, NIN_PAD, nullptr, gtid, gsz);
  transpose_w(p.w_out, 1024, 1024, p.Wt_out, 1024, nullptr, gtid, gsz);
  transpose_w(p.xa_wq, 1024, 1024, p.Wt_q, 1024, p.norm_xattn_w, gtid, gsz);
  transpose_w(p.xa_wk, 1024, 1024, p.Wt_k, 1024, nullptr, gtid, gsz);
  transpose_w(p.xa_wv, 1024, 1024, p.Wt_v, 1024, nullptr, gtid, gsz);
  transpose_w(p.xa_wo, 1024, 1024, p.Wt_o, 1024, nullptr, gtid, gsz);
  transpose_w(p.peer_wq, 1024, 2048, p.Wt_pq, 2048, p.norm_ffn_w, gtid, gsz);
  cvt_bf16(p.peer_keys1, p.keys1b, 8 * 128 * 128 / 8, gtid, gsz);
  cvt_bf16(p.peer_keys2, p.keys2b, 8 * 128 * 128 / 8, gtid, gsz);
  cvt_fp6(p.peer_u, (unsigned char*)p.Ub, (size_t)16384 * 1024 / 32, 64.f, gtid, gsz);
  cvt_fp4(p.peer_v, (unsigned char*)p.Vb, (size_t)16384 * 1024 / 32, 16.f, gtid, gsz);
  for (int i = gtid; i < 65536; i += gsz) { p.ss1[i] = 0.f; p.ss2[i] = 0.f; }
  const int gw = gtid >> 6, nw = gsz >> 6, lane = gtid & 63;
  for (int r = gw; r < 3072; r += nw) {
    const float* src = r < 2048 ? p.mem_prompt + (size_t)r * 1024 : p.mem_sample + (size_t)(r - 2048) * 1024;
    rms_row_bf16(src, p.norm_mem_w, p.memn + (size_t)r * 1024, lane);
  }
}

DEVI void phase_hb(const Params& p, int g) {
  const int gtid = blockIdx.x * NT + opq(threadIdx.x), gsz = gridDim.x * NT;
  const int gw = gtid >> 6, nw = gsz >> 6, lane = gtid & 63;
  const float* x = g ? p.x_sample : p.x_prompt;
  for (int r = gw; r < TG; r += nw) rms_row_bf16(x + (size_t)r * 1024, p.norm_mix_w, p.buf67 + (size_t)r * 1024, lane);
}


DEVI bool xcd_tile(int it, int TN, int& tm, int& tn) {
  const int x = blockIdx.x & 7, lb = blockIdx.x >> 3, nlb = gridDim.x >> 3;
  const int lt = lb + it * nlb;
  if (lb >= nlb || lt >= 16 * TN) return false;
  tn = (lt >> 2) % TN;
  tm = x * 16 + (lt / (4 * TN)) * 4 + (lt & 3);
  return true;
}

template <class F>
DEVI void epi256(const f32x4 (&acc)[8][4], int row0, int col0, F f) {
  const int tid_ = opq(threadIdx.x);
  const int lane = tid_ & 63, wid = tid_ >> 6, wr = wid >> 2, wc = wid & 3, fr = lane & 15, fq = lane >> 4;
#pragma unroll
  for (int m = 0; m < 8; ++m)
#pragma unroll
    for (int n = 0; n < 4; ++n) f(row0 + wr * 128 + m * 16 + fr, col0 + wc * 64 + n * 16 + fq * 4, acc[m][n]);
}

DEVI void phase_inproj(const Params& p, int g, char* smem) {
  const int n_main = 0;
  const int n_tiles = n_main + 128 + (g == 0 ? 48 + 48 : 0);
  {
    g8::EpiStoreBf16 E{p.z, ZW};
    g8::gemm_phase((G8_LAS unsigned char*)smem, p.buf67, 1024, p.Wt_in, TG, ZW, 1024, E);
  }
  for (int tile = blockIdx.x; tile < n_tiles; tile += gridDim.x) {
    if (tile < n_main) {
      int tm = tile / 14, tn = tile % 14;
      f32x4 acc[8][4];
      zero_acc(acc);
      gemm_core<256, 256, 2, 4, false>(p.buf67 + (size_t)tm * 256 * 1024, 1024, p.Wt_in + (size_t)tn * 256 * 1024, 1024, 1024, smem, acc);
      epi256(acc, tm * 256, tn * 256, [&](int row, int col, f32x4 v) {
        *(uint2*)(p.z + (size_t)row * ZW + col) = make_uint2(pack2(v[0], v[1]), pack2(v[2], v[3]));
      });
    } else if (tile < n_main + 128) {
      const int tid_ = opq(threadIdx.x);
      const int lane = tid_ & 63, wid = tid_ >> 6, wr = wid >> 1, wc = wid & 1, fr = lane & 15, fq = lane >> 4;
      int tm = tile - n_main;
      f32x4 acc[4][4];
      zero_acc(acc);
      gemm_core<256, 128, 4, 2, false>(p.buf67 + (size_t)tm * 256 * 1024, 1024, p.Wt_in + (size_t)ZW * 1024, 1024, 1024, smem, acc);
      if (wc == 0) {
#pragma unroll
        for (int m = 0; m < 4; ++m) {
          int row = tm * 256 + wr * 64 + m * 16 + fr;
          int c = fq * 4;
          float4 gb = *(const float4*)(p.gate_b + c);
          f32x4 v = acc[m][0];
          *(float4*)(p.gates + (size_t)row * 16 + c) = make_float4(v[0] + gb.x, v[1] + gb.y, v[2] + gb.z, v[3] + gb.w);
        }
      }
    } else if (tile < n_main + 128 + 48) {
      int t2 = tile - n_main - 128;
      int tm = t2 >> 2, tn = t2 & 3;
      f32x4 acc[8][4];
      zero_acc(acc);
      gemm_core<256, 256, 2, 4, false>(p.memn + (size_t)tm * 256 * 1024, 1024, p.Wt_k + (size_t)tn * 256 * 1024, 1024, 1024, smem, acc);
      epi256(acc, tm * 256, tn * 256, [&](int row, int col, f32x4 v) {
        *(uint2*)(p.Kmem + (size_t)row * 1024 + col) = make_uint2(pack2(v[0], v[1]), pack2(v[2], v[3]));
      });
    } else {
      int t2 = tile - n_main - 128 - 48;
      int tm = t2 / 12, tn = t2 % 12;
      f32x4 acc[8][4];
      zero_acc(acc);
      gemm_core<256, 256, 2, 4, false>(p.Wt_v + (size_t)tm * 256 * 1024, 1024, p.memn + (size_t)tn * 256 * 1024, 1024, 1024, smem, acc);
      epi256(acc, tm * 256, tn * 256, [&](int row, int col, f32x4 v) {
        *(uint2*)(p.VmemT + (size_t)row * 3072 + col) = make_uint2(pack2(v[0], v[1]), pack2(v[2], v[3]));
      });
    }
  }
}

DEVI float scan128_sum(float v, float* tmp) {
  const int tid_ = opq(threadIdx.x); const int lane = tid_ & 63, wid = tid_ >> 6;
#pragma unroll
  for (int o = 1; o < 64; o <<= 1) { float t = __shfl_up(v, o); if (lane >= o) v += t; }
  if (lane == 63) tmp[wid] = v;
  __syncthreads();
  if (wid == 1) v += tmp[0];
  __syncthreads();
  return v;
}
DEVI float scan128_max(float v, float* tmp) {
  const int tid_ = opq(threadIdx.x); const int lane = tid_ & 63, wid = tid_ >> 6;
#pragma unroll
  for (int o = 1; o < 64; o <<= 1) { float t = __shfl_up(v, o); if (lane >= o) v = fmaxf(v, t); }
  if (lane == 63) tmp[wid] = v;
  __syncthreads();
  if (wid == 1) v = fmaxf(v, tmp[0]);
  __syncthreads();
  return v;
}

DEVI void conv_part(const Params& p, int g) {
  const int gtid = blockIdx.x * NT + opq(threadIdx.x), gsz = gridDim.x * NT;
  const int seqmask = g ? 8191 : 4095;
  for (int idx = gtid; idx < TG * 64; idx += gsz) {
    int t = idx >> 6, c8 = idx & 63;
    int pos = t & seqmask;
    const us* zr = p.z + (size_t)t * ZW + c8 * 8;
    uint4 xt1 = *(const uint4*)(zr), bg1 = *(const uint4*)(zr + 512), cg1 = *(const uint4*)(zr + 1024);
    uint4 xt0 = make_uint4(0, 0, 0, 0), cg0 = xt0, xt2 = xt0, cg2 = xt0;
    if (pos > 0) { xt0 = *(const uint4*)(zr - ZW); cg0 = *(const uint4*)(zr - ZW + 1024); }
    if (pos < seqmask) { xt2 = *(const uint4*)(zr + ZW); cg2 = *(const uint4*)(zr + ZW + 1024); }
    const u32* a0 = (const u32*)&xt0; const u32* b0 = (const u32*)&cg0;
    const u32* a1 = (const u32*)&xt1; const u32* b1 = (const u32*)&cg1;
    const u32* a2 = (const u32*)&xt2; const u32* b2 = (const u32*)&cg2;
    const u32* gg = (const u32*)&bg1;
    u32 o[4];
#pragma unroll
    for (int i = 0; i < 4; ++i) {
      int c = c8 * 8 + 2 * i;
      float u0l = bflo(a0[i]) * bflo(b0[i]), u0h = bfhi(a0[i]) * bfhi(b0[i]);
      float u1l = bflo(a1[i]) * bflo(b1[i]), u1h = bfhi(a1[i]) * bfhi(b1[i]);
      float u2l = bflo(a2[i]) * bflo(b2[i]), u2h = bfhi(a2[i]) * bfhi(b2[i]);
      float cl = p.conv_w[c] * u0l + p.conv_w[512 + c] * u1l + p.conv_w[1024 + c] * u2l + p.conv_b[c];
      float ch = p.conv_w[c + 1] * u0h + p.conv_w[512 + c + 1] * u1h + p.conv_w[1024 + c + 1] * u2h + p.conv_b[c + 1];
      o[i] = pack2(bflo(gg[i]) * cl, bfhi(gg[i]) * ch);
    }
    *(uint4*)(p.buf67 + (size_t)t * 1024 + c8 * 8) = make_uint4(o[0], o[1], o[2], o[3]);
#if STAGE < 2
    *(uint4*)(p.buf67 + (size_t)t * 1024 + 512 + c8 * 8) = make_uint4(0, 0, 0, 0);
#endif
  }
}

DEVI void phase_local(const Params& p, int g, char* smem) {
  const int tid = opq(threadIdx.x), lane = tid & 63, wid = tid >> 6, wr = wid >> 1, wc = wid & 1, fr = lane & 15, fq = lane >> 4;
  us* VT = (us*)smem;
  us* KF = VT + 128 * 72;
  us* KB = KF + 128 * 72;
  float* scl = (float*)(KB + 128 * 72);
  float* tmp = scl + 256;
  for (int unit = blockIdx.x; unit < 1024; unit += gridDim.x) {
    const int cl = unit >> 2, h = unit & 3, t0 = cl * 128;
    __syncthreads();
#pragma unroll
    for (int d = 0; d < 2; ++d) {
      int l = d ? 127 - (tid & 127) : (tid & 127);
      const float* gr = p.gates + (size_t)(t0 + l) * 16;
      float ig = gr[d * 4 + h], fg = gr[8 + d * 4 + h];
      float a = scan128_sum(logsigf_(fg), tmp);
      if (tid == 127) tmp[16] = a;
      __syncthreads();
      float gtot = tmp[16];
      float w = gtot - a + ig;
      float wm = w;
#pragma unroll
      for (int o = 32; o >= 1; o >>= 1) wm = fmaxf(wm, __shfl_xor(wm, o));
      if (lane == 0) tmp[8 + wid] = wm;
      __syncthreads();
      float mloc = fmaxf(tmp[8], tmp[9]);
      if (tid < 128) scl[d * 128 + l] = __expf(w - mloc);
      if (tid == 0) { p.scstate[(unit * 2 + d) * 2] = gtot; p.scstate[(unit * 2 + d) * 2 + 1] = mloc; }
      __syncthreads();
    }
    f32x4 accF[2][4], accB[2][4];
    zero_acc(accF);
    zero_acc(accB);
    float nsum = 0.f;
    for (int lh = 0; lh < 2; ++lh) {
      __syncthreads();
      for (int idx = tid; idx < 1024; idx += NT) {
        int lrow = idx & 63, c8 = idx >> 6;
        int l = lh * 64 + lrow;
        const us* zr = p.z + (size_t)(t0 + l) * ZW + h * 128 + c8 * 8;
        uint4 kv = *(const uint4*)(zr + 2048), vv = *(const uint4*)(zr + 2560);
        float sf = scl[l], sb = scl[128 + l];
        const u32* kw = (const u32*)&kv; const u32* vw = (const u32*)&vv;
#pragma unroll
        for (int i = 0; i < 4; ++i) {
          int r0 = (c8 * 8 + 2 * i) * 72 + lrow, r1 = r0 + 72;
          float k0 = bflo(kw[i]), k1 = bfhi(kw[i]);
          KF[r0] = f2bf(k0 * sf); KF[r1] = f2bf(k1 * sf);
          KB[r0] = f2bf(k0 * sb); KB[r1] = f2bf(k1 * sb);
          VT[r0] = (us)(vw[i] & 0xffffu); VT[r1] = (us)(vw[i] >> 16);
        }
      }
      __syncthreads();
      mma_lds<128, 4, 2>(VT, 72, KF, 72, 64, accF);
      mma_lds<128, 4, 2>(VT, 72, KB, 72, 64, accB);
      if (tid < 256) {
        const us* kr = (tid < 128 ? KF : KB) + (tid & 127) * 72;
#pragma unroll
        for (int i = 0; i < 8; ++i) {
          uint4 q = *(const uint4*)(kr + i * 8);
          nsum += bflo(q.x) + bfhi(q.x) + bflo(q.y) + bfhi(q.y) + bflo(q.z) + bfhi(q.z) + bflo(q.w) + bfhi(q.w);
        }
      }
    }
    if (tid < 256) p.nstate[(size_t)(unit * 2 + (tid >> 7)) * 128 + (tid & 127)] = nsum;
    us* cf = p.states + (size_t)(unit * 2) * 16384;
    us* cb = cf + 16384;
#pragma unroll
    for (int m = 0; m < 2; ++m)
#pragma unroll
      for (int n = 0; n < 4; ++n) {
        int dv = wr * 32 + m * 16 + fr, dk = wc * 64 + n * 16 + fq * 4;
        f32x4 v = accF[m][n];
        *(uint2*)(cf + dv * 128 + dk) = make_uint2(pack2(v[0], v[1]), pack2(v[2], v[3]));
        v = accB[m][n];
        *(uint2*)(cb + dv * 128 + dk) = make_uint2(pack2(v[0], v[1]), pack2(v[2], v[3]));
      }
  }
}

DEVI void phase_scan(const Params& p, int g) {
  const int tid = opq(threadIdx.x);
  const int nc = g ? 64 : 32;
  const int nitems = (g ? 4 : 8) * 64;
  for (int item = blockIdx.x; item < nitems; item += gridDim.x) {
    const int slice = item & 7, d = (item >> 3) & 1, h = (item >> 4) & 3, sq = item >> 6;
    const bool nrow = (slice == 0) && (tid < 128);
    float C[4] = {0.f, 0.f, 0.f, 0.f};
    float m = -1e30f, nacc = 0.f;
    const size_t toff = (size_t)slice * 2048 + tid * 4;
    uint2 cl[4];
    float2 gmv[4];
    float nlv[4];
#pragma unroll
    for (int j = 0; j < 4; ++j) {
      int c = d ? nc - 1 - j : j;
      size_t U = (size_t)(((sq * nc + c) * 4 + h) * 2 + d);
      cl[j] = *(const uint2*)(p.states + U * 16384 + toff);
      gmv[j] = *(const float2*)(p.scstate + U * 2);
      nlv[j] = nrow ? p.nstate[U * 128 + tid] : 0.f;
    }
#pragma unroll 1
    for (int cc0 = 0; cc0 < nc; cc0 += 4) {
#pragma unroll
      for (int j = 0; j < 4; ++j) {
        const int cc = cc0 + j;
        const int c = d ? nc - 1 - cc : cc;
        const size_t U = (size_t)(((sq * nc + c) * 4 + h) * 2 + d);
        us* ptr = p.states + U * 16384 + toff;
        const uint2 clv = cl[j];
        const float2 gm = gmv[j];
        const float nl = nlv[j];
        if (cc + 4 < nc) {
          const int c2 = d ? c - 4 : c + 4;
          const size_t U2 = (size_t)(((sq * nc + c2) * 4 + h) * 2 + d);
          cl[j] = *(const uint2*)(p.states + U2 * 16384 + toff);
          gmv[j] = *(const float2*)(p.scstate + U2 * 2);
          nlv[j] = nrow ? p.nstate[U2 * 128 + tid] : 0.f;
        }
        const float gch = gm.x, mloc = gm.y;
        const float mn = fmaxf(gch + m, mloc);
        const float dec = __expf(gch + m - mn), sc = __expf(mloc - mn);
        *(uint2*)ptr = make_uint2(pack2(C[0], C[1]), pack2(C[2], C[3]));
        if (nrow) {
          p.nprev[U * 128 + tid] = nacc;
          nacc = dec * nacc + sc * nl;
        }
        if (slice == 0 && tid == 0) p.mprev[U] = m;
        C[0] = dec * C[0] + sc * bflo(clv.x);
        C[1] = dec * C[1] + sc * bfhi(clv.x);
        C[2] = dec * C[2] + sc * bflo(clv.y);
        C[3] = dec * C[3] + sc * bfhi(clv.y);
        m = mn;
      }
    }
  }
}

DEVI void phase_mlout(const Params& p, int g, char* smem) {
  const int tid = opq(threadIdx.x), lane = tid & 63, wid = tid >> 6, fr = lane & 15, fq = lane >> 4;
  us* Pl = (us*)smem;
  us* VT = (us*)(smem + 34816);
  char* stage = smem + 34816;
  float* vec = (float*)(smem + 34816 + 65536);
  float* bv = vec; float* Mv = vec + 256; float* einv = vec + 512; float* emt = vec + 768; float* qn = vec + 1024;
  float* tmp = vec + 1280;
  for (int unit = blockIdx.x; unit < 1024; unit += gridDim.x) {
    const int cl = unit >> 2, h = unit & 3, t0 = cl * 128;
    __syncthreads();
#pragma unroll
    for (int d = 0; d < 2; ++d) {
      int l = d ? 127 - (tid & 127) : (tid & 127);
      const float* gr = p.gates + (size_t)(t0 + l) * 16;
      float ig = gr[d * 4 + h], fg = gr[8 + d * 4 + h];
      float a = scan128_sum(logsigf_(fg), tmp);
      float b = ig - a;
      float pm = scan128_max(b, tmp);
      float mp = p.mprev[unit * 2 + d];
      float M = fmaxf(mp, pm);
      if (tid < 128) {
        bv[d * 128 + l] = b; Mv[d * 128 + l] = M; einv[d * 128 + l] = __expf(mp - M); emt[d * 128 + l] = __expf(-(a + M));
      }
    }
    if (tid < 256) {
      int d = tid >> 7, t = tid & 127;
      const us* qr = p.z + (size_t)(t0 + t) * ZW + 1536 + h * 128;
      const float* nr = p.nprev + (size_t)(unit * 2 + d) * 128;
      float s = 0.f;
#pragma unroll 8
      for (int i = 0; i < 16; ++i) {
        uint4 q = *(const uint4*)(qr + i * 8);
        float4 n0 = *(const float4*)(nr + i * 8), n1 = *(const float4*)(nr + i * 8 + 4);
        s += bflo(q.x) * n0.x + bfhi(q.x) * n0.y + bflo(q.y) * n0.z + bfhi(q.y) * n0.w + bflo(q.z) * n1.x + bfhi(q.z) * n1.y +
             bflo(q.w) * n1.z + bfhi(q.w) * n1.w;
      }
      qn[d * 128 + t] = s * QS;
    }
    __syncthreads();
    const us* zq = p.z + (size_t)t0 * ZW + 1536 + h * 128;
    const us* zk = p.z + (size_t)t0 * ZW + 2048 + h * 128;
    f32x4 sacc[1][8], pb[1][8];
    zero_acc(sacc);
    gemm_core<128, 128, 8, 1, false>(zq, ZW, zk, ZW, 128, stage, sacc);
    const int t = wid * 16 + fr;
    float cF, cB;
    {
      float Mf = Mv[t], Mb = Mv[128 + t];
      float rf = 0.f, rb = 0.f;
#pragma unroll
      for (int n = 0; n < 8; ++n)
#pragma unroll
        for (int j = 0; j < 4; ++j) {
          int s = n * 16 + fq * 4 + j;
          float sv = sacc[0][n][j] * QS;
          float pf = 0.f, pbv = 0.f;
          if (n <= wid) pf = (s <= t) ? sv * __expf(bv[s] - Mf) : 0.f;
          if (n >= wid) pbv = (s >= t) ? sv * __expf(bv[128 + s] - Mb) : 0.f;
          rf += pf; rb += pbv;
          sacc[0][n][j] = pf; pb[0][n][j] = pbv;
          if (j == 3) __builtin_amdgcn_sched_barrier(0);
        }
      rf += __shfl_xor(rf, 16); rf += __shfl_xor(rf, 32);
      rb += __shfl_xor(rb, 16); rb += __shfl_xor(rb, 32);
      float denf = rf + einv[t] * qn[t], denb = rb + einv[128 + t] * qn[128 + t];
      float invf = 1.f / fmaxf(fabsf(denf), emt[t]), invb = 1.f / fmaxf(fabsf(denb), emt[128 + t]);
      cF = einv[t] * QS * invf; cB = einv[128 + t] * QS * invb;
#pragma unroll
      for (int n = 0; n < 8; ++n) {
        f32x4 a = sacc[0][n], b = pb[0][n];
        *(uint2*)(Pl + t * 136 + n * 16 + fq * 4) = make_uint2(pack2(a[0] * invf + b[0] * invb, a[1] * invf + b[1] * invb),
                                                                pack2(a[2] * invf + b[2] * invb, a[3] * invf + b[3] * invb));
        __builtin_amdgcn_sched_barrier(0);
      }
    }
    f32x4 acc[1][8];
    zero_acc(sacc);
    gemm_core<128, 128, 8, 1, false>(zq, ZW, p.states + (size_t)(unit * 2) * 16384, 128, 128, stage, sacc);
#pragma unroll
    for (int n = 0; n < 8; ++n) acc[0][n] = sacc[0][n] * cF;
    zero_acc(sacc);
    gemm_core<128, 128, 8, 1, false>(zq, ZW, p.states + (size_t)(unit * 2 + 1) * 16384, 128, 128, stage, sacc);
#pragma unroll
    for (int n = 0; n < 8; ++n) acc[0][n] += sacc[0][n] * cB;
    for (int idx = tid; idx < 2048; idx += NT) {
      int l = idx & 127, c8 = idx >> 7;
      uint4 vv = *(const uint4*)(p.z + (size_t)(t0 + l) * ZW + 2560 + h * 128 + c8 * 8);
      const u32* vw = (const u32*)&vv;
#pragma unroll
      for (int i = 0; i < 4; ++i) {
        VT[(c8 * 8 + 2 * i) * 136 + l] = (us)(vw[i] & 0xffffu);
        VT[(c8 * 8 + 2 * i + 1) * 136 + l] = (us)(vw[i] >> 16);
      }
    }
    __syncthreads();
    mma_lds<128, 8, 1>(Pl, 136, VT, 136, 128, acc);
    {
      float ss = 0.f;
#pragma unroll
      for (int n = 0; n < 8; ++n)
#pragma unroll
        for (int j = 0; j < 4; ++j) ss += acc[0][n][j] * acc[0][n][j];
      ss += __shfl_xor(ss, 16); ss += __shfl_xor(ss, 32);
      float rs = rsqrtf(ss * (1.f / 128.f) + EPS);
#pragma unroll
      for (int n = 0; n < 8; ++n) {
        int col = h * 128 + n * 16 + fq * 4;
        uint2 ov = *(const uint2*)(p.z + (size_t)(t0 + t) * ZW + 3072 + col);
        float4 w4 = *(const float4*)(p.mlstm_norm_w + col);
        f32x4 v = acc[0][n];
        float y0 = v[0] * rs * w4.x * sigmoidf_(bflo(ov.x)), y1 = v[1] * rs * w4.y * sigmoidf_(bfhi(ov.x));
        float y2 = v[2] * rs * w4.z * sigmoidf_(bflo(ov.y)), y3 = v[3] * rs * w4.w * sigmoidf_(bfhi(ov.y));
        *(uint2*)(p.buf67 + (size_t)(t0 + t) * 1024 + 512 + col) = make_uint2(pack2(y0, y1), pack2(y2, y3));
      }
    }
  }
}

template <bool XF32>
DEVI void phase_resid_gemm(const Params& p, int g, const us* A, const us* Wt, const float* xold, float* ss, us* xout, int ldo, char* smem) {
  g8::EpiResid<XF32> E{xold, p.xb, xout, ldo, ss + g * TG};
  g8::gemm_phase((G8_LAS unsigned char*)smem, A, 1024, Wt, TG, 1024, 1024, E);
}

DEVI void phase_proj(const Params& p, int g, const us* A, int lda, const us* Wt, int N, const float* ss, us* O, char* smem) {
  g8::EpiScaleBf16 E{O, N, ss + g * TG};
  g8::gemm_phase((G8_LAS unsigned char*)smem, A, lda, Wt, TG, N, 1024, E);
}

DEVI void phase_xattn(const Params& p, int g, char* smem) {
  const int tid = opq(threadIdx.x), lane = tid & 63, wid = tid >> 6, fr = lane & 15, fq = lane >> 4;
  us* Pl = (us*)smem;
  char* stage2 = smem + 67584;
  for (int unit = blockIdx.x; unit < 1024; unit += gridDim.x) {
    const int tile = unit >> 2, h = unit & 3, t0 = tile * 128;
    const int mb = g ? 2048 + (t0 >> 13) * 256 : (t0 >> 12) * 256;
    __syncthreads();
    f32x4 sacc[1][16];
    zero_acc(sacc);
    gemm_core<128, 256, 8, 1, false>(p.Qb + (size_t)t0 * 1024 + h * 256, 1024, p.Kmem + (size_t)mb * 1024 + h * 256, 1024, 256, smem, sacc);
    const int t = wid * 16 + fr;
    float linv;
    {
      float mx = -3.0e38f;
#pragma unroll
      for (int n = 0; n < 16; ++n)
#pragma unroll
        for (int j = 0; j < 4; ++j) mx = fmaxf(mx, sacc[0][n][j]);
      mx = fmaxf(mx, __shfl_xor(mx, 16)); mx = fmaxf(mx, __shfl_xor(mx, 32));
      float sum = 0.f;
#pragma unroll
      for (int n = 0; n < 16; ++n) {
        f32x4 a;
#pragma unroll
        for (int j = 0; j < 4; ++j) { a[j] = __expf((sacc[0][n][j] - mx) * 0.0625f); sum += a[j]; }
        *(uint2*)(Pl + t * 264 + n * 16 + fq * 4) = make_uint2(pack2(a[0], a[1]), pack2(a[2], a[3]));
      }
      sum += __shfl_xor(sum, 16); sum += __shfl_xor(sum, 32);
      linv = 1.f / sum;
    }
    zero_acc(sacc);
    gemm_core<128, 256, 8, 1, true>(Pl, 264, p.VmemT + (size_t)(h * 256) * 3072 + mb, 3072, 256, stage2, sacc);
#pragma unroll
    for (int n = 0; n < 16; ++n) {
      f32x4 a = sacc[0][n] * linv;
      *(uint2*)(p.Ob + (size_t)(t0 + t) * 1024 + h * 256 + n * 16 + fq * 4) = make_uint2(pack2(a[0], a[1]), pack2(a[2], a[3]));
    }
  }
}

DEVI void top16_of_128(const f32x4 (&sc)[8], int fq, u32 (&sel)[16]) {
  u32 v[32];
#pragma unroll
  for (int n = 0; n < 8; ++n)
#pragma unroll
    for (int j = 0; j < 4; ++j) {
      int key = n * 16 + fq * 4 + j;
      v[n * 4 + j] = ((ordf(sc[n][j]) >> 1) & ~127u) | (u32)(127 - key);
    }
  u32 prev = 0x80000000u;
#pragma unroll
  for (int k = 0; k < 16; ++k) {
    u32 base = prev - 1u;
    u32 d = base - v[0];
#pragma unroll
    for (int i = 1; i < 32; ++i) d = min(d, base - v[i]);
    d = min(d, (u32)__shfl_xor((int)d, 16));
    d = min(d, (u32)__shfl_xor((int)d, 32));
    prev = base - d;
    sel[k] = prev;
  }
}

DEVI void phase_topk(const Params& p, int g, char* smem) {
  const int tid = opq(threadIdx.x), lane = tid & 63, wid = tid >> 6, fr = lane & 15, fq = lane >> 4;
  int* il = (int*)(smem + 65536);
  bool pre = false;
  for (int unit = blockIdx.x; unit < 2048; unit += gridDim.x) {
    const int tile = unit >> 3, h = unit & 7, t0 = tile * 128;
    u32 sel[2][16];
    const us* a0p = p.pq + (size_t)t0 * 2048 + h * 256;
    {
      f32x4 sc[1][8];
      zero_acc(sc);
      if (pre) gemm_core<128, 128, 8, 1, false, true>(a0p, 2048, p.keys1b + (size_t)h * 16384, 128, 128, smem, sc);
      else gemm_core<128, 128, 8, 1, false, false>(a0p, 2048, p.keys1b + (size_t)h * 16384, 128, 128, smem, sc);
      gemm_issue0<128, 128, false>(a0p + 128, 2048, p.keys2b + (size_t)h * 16384, 128, smem);
      top16_of_128(sc[0], fq, sel[0]);
    }
    {
      f32x4 sc[1][8];
      zero_acc(sc);
      gemm_core<128, 128, 8, 1, false, true>(a0p + 128, 2048, p.keys2b + (size_t)h * 16384, 128, 128, smem, sc);
      const int un = unit + gridDim.x;
      pre = un < 2048;
      if (pre) gemm_issue0<128, 128, false>(p.pq + (size_t)(un >> 3) * 128 * 2048 + (un & 7) * 256, 2048, p.keys1b + (size_t)(un & 7) * 16384, 128, smem);
      top16_of_128(sc[0], fq, sel[1]);
    }
    {
      const int t = wid * 16 + fr;
      float v1[16], v2[16];
#pragma unroll
      for (int k = 0; k < 16; ++k) {
        v1[k] = unordf((sel[0][k] & ~127u) << 1);
        v2[k] = unordf((sel[1][k] & ~127u) << 1);
        il[(t * 2 + 0) * 16 + k] = 127 - (int)(sel[0][k] & 127u);
        il[(t * 2 + 1) * 16 + k] = 127 - (int)(sel[1][k] & 127u);
      }
      u32 c[50];
      {
        int ci = 0;
#pragma unroll
        for (int a = 0; a < 16; ++a)
#pragma unroll
          for (int b = 0; b < 16; ++b)
            if ((a + 1) * (b + 1) <= 16) { c[ci] = ((ordf(v1[a] + v2[b]) >> 1) & ~255u) | (u32)(255 - (a * 16 + b)); ++ci; }
      }
      u32 prev = 0x80000000u;
      float sv[16];
      int se[16];
#pragma unroll
      for (int k = 0; k < 16; ++k) {
        u32 base = prev - 1u;
        u32 d = base - c[0];
#pragma unroll
        for (int i = 1; i < 50; ++i) d = min(d, base - c[i]);
        prev = base - d;
        int code = 255 - (int)(prev & 255u);
        sv[k] = unordf((prev & ~255u) << 1);
        se[k] = il[(t * 2 + 0) * 16 + (code >> 4)] * 128 + il[(t * 2 + 1) * 16 + (code & 15)];
      }
      const float mxv = sv[0];
      float tot = 0.f;
#pragma unroll
      for (int k = 0; k < 16; ++k) { sv[k] = __expf(sv[k] - mxv); tot += sv[k]; }
      const float inv = 1.f / tot;
      if (fq == 0) {
        size_t ob = (size_t)(t0 + t) * 128 + h * 16;
#pragma unroll
        for (int k = 0; k < 16; k += 4) {
          *(int4*)(p.eidx + ob + k) = make_int4(se[k], se[k + 1], se[k + 2], se[k + 3]);
          *(float4*)(p.gatew + ob + k) = make_float4(sv[k] * inv, sv[k + 1] * inv, sv[k + 2] * inv, sv[k + 3] * inv);
        }
      }
    }
  }
}

DEVI void phase_gather(const Params& p, int g, char* smem) {
  const int tid_ = opq(threadIdx.x);
  const int lane = tid_ & 63, wid = tid_ >> 6, r = lane & 15, q = lane >> 4;
  const int hh = lane >> 5, l = lane & 31;
  const int cbase = l * 32 + hh * 16;
  char* wbase = smem + wid * 18688;
  char* ubuf = wbase;
  us* hrow = (us*)(wbase + 12416);
  float* wl = (float*)(wbase + 12416 + 2048);
  int* el = (int*)(wbase + 12416 + 2560);
  const unsigned char* U8 = (const unsigned char*)p.Ub;
  const unsigned char* V6 = (const unsigned char*)p.Vb;
  for (int tok = blockIdx.x * 8 + wid; tok < TG; tok += gridDim.x * 8) {
    const size_t gt = (size_t)g * TG + tok;
    float* xr = p.out + gt * 1024 + cbase;
    float4 xa[4];
    {
      const uint4* xbr = (const uint4*)((const us*)(p.out + gt * 1024) + cbase);
      uint4 x0 = xbr[0], x1 = xbr[1];
      xa[0] = make_float4(bflo(x0.x), bfhi(x0.x), bflo(x0.y), bfhi(x0.y));
      xa[1] = make_float4(bflo(x0.z), bfhi(x0.z), bflo(x0.w), bfhi(x0.w));
      xa[2] = make_float4(bflo(x1.x), bfhi(x1.x), bflo(x1.y), bfhi(x1.y));
      xa[3] = make_float4(bflo(x1.z), bfhi(x1.z), bflo(x1.w), bfhi(x1.w));
    }
    const float rs2 = rsqrtf(p.ss2[gt] * (1.f / 1024.f) + EPS);
    {
      const float* w = p.norm_ffn_w + cbase;
      asm volatile("" : "+v"(w));
      u32 hw[8];
#pragma unroll
      for (int i = 0; i < 4; ++i) {
        float4 w4 = *(const float4*)(w + i * 4);
        hw[2 * i] = pack2(xa[i].x * rs2 * w4.x, xa[i].y * rs2 * w4.y);
        hw[2 * i + 1] = pack2(xa[i].z * rs2 * w4.z, xa[i].w * rs2 * w4.w);
      }
      *(uint4*)(hrow + cbase) = make_uint4(hw[0], hw[1], hw[2], hw[3]);
      *(uint4*)(hrow + cbase + 8) = make_uint4(hw[4], hw[5], hw[6], hw[7]);
    }
    el[lane] = p.eidx[(size_t)tok * 128 + lane];
    el[64 + lane] = p.eidx[(size_t)tok * 128 + 64 + lane];
    __builtin_amdgcn_wave_barrier();
    asm volatile("s_waitcnt vmcnt(0) lgkmcnt(0)" ::: "memory");
    float o[32];
#pragma unroll
    for (int i = 0; i < 32; ++i) o[i] = 0.f;
#pragma unroll 1
    for (int gi = 0; gi < 9; ++gi) {
      uint4 vv[4];
      if (gi > 0) {
#pragma unroll
        for (int k = 0; k < 4; ++k) {
          u32 e = (u32)el[(gi - 1) * 16 + 2 * k + hh];
          vv[k] = *(const uint4*)(V6 + (e * 512u + (u32)l * 16u));
        }
      }
      if (gi < 8) {
#pragma unroll
        for (int j = 0; j < 4; ++j) {
          const u32 e0 = (u32)el[gi * 16 + 4 * j], e1 = (u32)el[gi * 16 + 4 * j + 1], e2 = (u32)el[gi * 16 + 4 * j + 2], e3 = (u32)el[gi * 16 + 4 * j + 3];
#pragma unroll
          for (int t = 0; t < 3; ++t) {
            const int C = t * 64 + lane;
            const int i = (C >= 144) ? 3 : (C >= 96) ? 2 : (C >= 48) ? 1 : 0;
            int cs = C - i * 48 - 4 * i;
            cs = cs < 0 ? cs + 48 : cs;
            const u32 e = (i == 0) ? e0 : (i == 1) ? e1 : (i == 2) ? e2 : e3;
            __builtin_amdgcn_global_load_lds((const u32*)(U8 + (e * 768u + (u32)(cs << 4))), (u32*)(ubuf + j * 3088 + t * 1024), 16, 0, 0);
          }
        }
      }
      if (gi > 0) {
        if (gi < 8) asm volatile("s_waitcnt vmcnt(12)" ::: "memory");
        else asm volatile("s_waitcnt vmcnt(0)" ::: "memory");
#pragma unroll
        for (int k = 0; k < 4; ++k) {
          const float wk = wl[(gi - 1) * 16 + 2 * k + hh];
          const u32 vw[4] = {vv[k].x, vv[k].y, vv[k].z, vv[k].w};
#pragma unroll
          for (int d = 0; d < 4; ++d) {
            v2f r0 = __builtin_amdgcn_cvt_scalef32_pk_f32_fp4(vw[d], 1.0f, 0);
            v2f r1 = __builtin_amdgcn_cvt_scalef32_pk_f32_fp4(vw[d], 1.0f, 1);
            v2f r2 = __builtin_amdgcn_cvt_scalef32_pk_f32_fp4(vw[d], 1.0f, 2);
            v2f r3 = __builtin_amdgcn_cvt_scalef32_pk_f32_fp4(vw[d], 1.0f, 3);
            o[d * 8 + 0] += wk * r0[0]; o[d * 8 + 1] += wk * r0[1]; o[d * 8 + 2] += wk * r1[0]; o[d * 8 + 3] += wk * r1[1];
            o[d * 8 + 4] += wk * r2[0]; o[d * 8 + 5] += wk * r2[1]; o[d * 8 + 6] += wk * r3[0]; o[d * 8 + 7] += wk * r3[1];
          }
        }
#pragma unroll
        for (int k = 0; k < 4; ++k) {
          u32 e = (u32)el[(gi - 1) * 16 + 8 + 2 * k + hh];
          vv[k] = *(const uint4*)(V6 + (e * 512u + (u32)l * 16u));
        }
      }
      asm volatile("s_waitcnt vmcnt(0)" ::: "memory");
      if (gi > 0) {
#pragma unroll
        for (int k = 0; k < 4; ++k) {
          const float wk = wl[(gi - 1) * 16 + 8 + 2 * k + hh];
          const u32 vw[4] = {vv[k].x, vv[k].y, vv[k].z, vv[k].w};
#pragma unroll
          for (int d = 0; d < 4; ++d) {
            v2f r0 = __builtin_amdgcn_cvt_scalef32_pk_f32_fp4(vw[d], 1.0f, 0);
            v2f r1 = __builtin_amdgcn_cvt_scalef32_pk_f32_fp4(vw[d], 1.0f, 1);
            v2f r2 = __builtin_amdgcn_cvt_scalef32_pk_f32_fp4(vw[d], 1.0f, 2);
            v2f r3 = __builtin_amdgcn_cvt_scalef32_pk_f32_fp4(vw[d], 1.0f, 3);
            o[d * 8 + 0] += wk * r0[0]; o[d * 8 + 1] += wk * r0[1]; o[d * 8 + 2] += wk * r1[0]; o[d * 8 + 3] += wk * r1[1];
            o[d * 8 + 4] += wk * r2[0]; o[d * 8 + 5] += wk * r2[1]; o[d * 8 + 6] += wk * r3[0]; o[d * 8 + 7] += wk * r3[1];
          }
        }
      }
      if (gi < 8) {
        f32x4 acc = {0.f, 0.f, 0.f, 0.f};
#pragma unroll
        for (int s2 = 0; s2 < 8; ++s2) {
          const char* rowb = ubuf + (r >> 2) * 3088 + (r & 3) * 768;
          uint2 apc[3];
#pragma unroll
          for (int pc = 0; pc < 3; ++pc) {
            const int bo = s2 * 96 + q * 24 + pc * 8;
            int cp = (bo >> 4) + 4 * (r & 3);
            cp = cp >= 48 ? cp - 48 : cp;
            apc[pc] = *(const uint2*)(rowb + cp * 16 + (bo & 8));
          }
          uint2 a0 = apc[0], a1 = apc[1], a2 = apc[2];
          v6i pk = {(int)a0.x, (int)a0.y, (int)a1.x, (int)a1.y, (int)a2.x, (int)a2.y};
          const v32s ub = __builtin_bit_cast(v32s, __builtin_amdgcn_cvt_scalef32_pk32_bf16_fp6(pk, 1.0f));
          const bf16x8* bp = (const bf16x8*)(hrow + s2 * 128 + q * 32);
#pragma unroll
          for (int g2 = 0; g2 < 4; ++g2) {
            bf16x8 a8 = {ub[8 * g2], ub[8 * g2 + 1], ub[8 * g2 + 2], ub[8 * g2 + 3], ub[8 * g2 + 4], ub[8 * g2 + 5], ub[8 * g2 + 6], ub[8 * g2 + 7]};
            acc = __builtin_amdgcn_mfma_f32_16x16x32_bf16(a8, bp[g2], acc, 0, 0, 0);
          }
        }
        if (r == 0) {
          int idx = gi * 16 + q * 4;
          float4 gw = *(const float4*)(p.gatew + (size_t)tok * 128 + idx);
          *(float4*)(wl + idx) = make_float4(gw.x * gelu_tanh(acc[0] * 0.015625f), gw.y * gelu_tanh(acc[1] * 0.015625f),
                                             gw.z * gelu_tanh(acc[2] * 0.015625f), gw.w * gelu_tanh(acc[3] * 0.015625f));
        }
        asm volatile("s_waitcnt lgkmcnt(0)" ::: "memory");
      }
    }
#pragma unroll
    for (int i = 0; i < 32; ++i) o[i] += __shfl_xor(o[i], 32);
    float ss = 0.f;
#pragma unroll
    for (int i = 0; i < 4; ++i) {
      const float o0 = hh ? o[16 + i * 4] : o[i * 4], o1 = hh ? o[16 + i * 4 + 1] : o[i * 4 + 1];
      const float o2 = hh ? o[16 + i * 4 + 2] : o[i * 4 + 2], o3 = hh ? o[16 + i * 4 + 3] : o[i * 4 + 3];
      xa[i].x += o0 * 0.0625f; xa[i].y += o1 * 0.0625f; xa[i].z += o2 * 0.0625f; xa[i].w += o3 * 0.0625f;
      ss += xa[i].x * xa[i].x + xa[i].y * xa[i].y + xa[i].z * xa[i].z + xa[i].w * xa[i].w;
    }
    ss = wave_sum(ss);
    const float rf = rsqrtf(ss * (1.f / 1024.f) + EPS);
    const float* wf = p.norm_final_w + cbase;
    asm volatile("" : "+v"(wf));
#pragma unroll
    for (int i = 0; i < 4; ++i) {
      float4 w4 = *(const float4*)(wf + i * 4);
      *(float4*)(xr + i * 4) = make_float4(xa[i].x * rf * w4.x, xa[i].y * rf * w4.y, xa[i].z * rf * w4.z, xa[i].w * rf * w4.w);
    }
    __builtin_amdgcn_wave_barrier();
    asm volatile("s_waitcnt lgkmcnt(0)" ::: "memory");
  }
}

DEVI void phase_final_simple(const Params& p, int g) {
  const int gtid = blockIdx.x * NT + opq(threadIdx.x), gsz = gridDim.x * NT;
  const int gw = gtid >> 6, nw = gsz >> 6, lane = gtid & 63;
  for (int r = gw; r < TG; r += nw) {
    float* xr = p.out + ((size_t)g * TG + r) * 1024;
    float4 v[4];
    float ss = 0.f;
#pragma unroll
    for (int i = 0; i < 4; ++i) {
      v[i] = ((const float4*)xr)[i * 64 + lane];
      ss += v[i].x * v[i].x + v[i].y * v[i].y + v[i].z * v[i].z + v[i].w * v[i].w;
    }
    ss = wave_sum(ss);
    float rs = rsqrtf(ss * (1.f / 1024.f) + EPS);
#pragma unroll
    for (int i = 0; i < 4; ++i) {
      float4 w = ((const float4*)p.norm_final_w)[i * 64 + lane];
      ((float4*)xr)[i * 64 + lane] = make_float4(v[i].x * rs * w.x, v[i].y * rs * w.y, v[i].z * rs * w.z, v[i].w * rs * w.w);
    }
  }
}


#define XB_TMO      128
#define XB_XCNT(j)  (256  + 64 * (j))
#define XB_XSUB(j)  (1280 + 64 * (j))
#define XB_XGEN(j)  (2304 + 64 * (j))
#define XB_TOP      3328
#define XB_TOPGEN   3392
#define XCD_BAR_WORDS 3456
#define XB_SPIN_CAP (1u << 20)
#define LAS __attribute__((address_space(3)))
DEVI unsigned xb_ld(unsigned* p) { return __hip_atomic_load(p, __ATOMIC_RELAXED, __HIP_MEMORY_SCOPE_AGENT); }
DEVI unsigned xb_add(unsigned* p, unsigned v) { return __hip_atomic_fetch_add(p, v, __ATOMIC_RELAXED, __HIP_MEMORY_SCOPE_AGENT); }
DEVI unsigned xb_xcc_id() { return (unsigned)__builtin_amdgcn_s_getreg((3 << 11) | 20) & 0xFu; }
#define XB_SPIN(cond, bar) do { unsigned _sp = 0; while (cond) { __builtin_amdgcn_s_sleep(1); \
    if ((++_sp & 255u) == 0u) { if (xb_ld(&(bar)[XB_TMO])) break; if (_sp > XB_SPIN_CAP) { atomicAdd(&(bar)[XB_TMO], 1u); break; } } } } while (0)
struct XcdBarrier { unsigned* bar; unsigned x; volatile LAS unsigned* st; };
DEVI XcdBarrier xcd_barrier_post(unsigned* bar, volatile LAS unsigned* st) {
  XcdBarrier b; b.bar = bar; b.x = xb_xcc_id(); b.st = st;
  if (threadIdx.x == 0) (void)xb_add(&bar[XB_XCNT(b.x)], 1u);
  return b;
}
DEVI void xcd_barrier_complete(unsigned* bar, unsigned x, unsigned& nloc, unsigned& nx) {
  const unsigned G = gridDim.x * gridDim.y * gridDim.z;
  unsigned sum, cnt, mine, sp = 0u;
  for (;;) {
    sum = 0u; cnt = 0u; mine = 0u;
#pragma unroll
    for (unsigned j = 0; j < 16; ++j) { const unsigned c = xb_ld(&bar[XB_XCNT(j)]); sum += c; cnt += (c > 0u) ? 1u : 0u; mine = (j == x) ? c : mine; }
    if (sum == G) break;
    __builtin_amdgcn_s_sleep(1);
    if ((++sp & 255u) == 0u) { if (xb_ld(&bar[XB_TMO])) break; if (sp > XB_SPIN_CAP) { atomicAdd(&bar[XB_TMO], 1u); break; } }
  }
  nloc = mine > 0u ? mine : 1u; nx = cnt > 0u ? cnt : 1u;
}
DEVI void xcd_barrier(const XcdBarrier& b) {
  asm volatile("s_waitcnt vmcnt(0)" ::: "memory");
  __syncthreads();
  if (threadIdx.x == 0) {
    unsigned* bar = b.bar;
    __builtin_amdgcn_s_waitcnt(0);
    unsigned nloc = b.st[0], nx = b.st[1];
    if (nloc == 0u) { xcd_barrier_complete(bar, b.x, nloc, nx); b.st[0] = nloc; b.st[1] = nx; }
    const unsigned old = xb_add(&bar[XB_XSUB(b.x)], 1u);
    const unsigned gen = old / nloc;
    if (old + 1u == (gen + 1u) * nloc) {
      __builtin_amdgcn_fence(__ATOMIC_RELEASE, "agent");
      asm volatile("s_waitcnt vmcnt(0)" ::: "memory");
      const unsigned og = xb_add(&bar[XB_TOP], 1u);
      const unsigned tg = og / nx;
      if (og + 1u == (tg + 1u) * nx) xb_add(&bar[XB_TOPGEN], 1u);
      else XB_SPIN(xb_ld(&bar[XB_TOPGEN]) == tg, bar);
      __builtin_amdgcn_fence(__ATOMIC_ACQUIRE, "agent");
      xb_add(&bar[XB_XGEN(b.x)], 1u);
      asm volatile("s_waitcnt vmcnt(0)" ::: "memory");
    } else {
      XB_SPIN(xb_ld(&bar[XB_XGEN(b.x)]) == gen, bar);
      __builtin_amdgcn_fence(__ATOMIC_ACQUIRE, "agent");
      asm volatile("s_waitcnt vmcnt(0)" ::: "memory");
    }
  }
  __syncthreads();
}

__global__ void __launch_bounds__(NT, 2) mega(Params p, int pb, int pe) {
  extern __shared__ __attribute__((aligned(16))) char smem[];
  cg::grid_group grid = cg::this_grid();
  volatile LAS unsigned* xst = (volatile LAS unsigned*)(smem + LDS_BYTES - 16);
  if (threadIdx.x == 0) { xst[0] = 0u; xst[1] = 0u; }
  __syncthreads();
  XcdBarrier xb;
  xb.bar = p.bar; xb.x = xb_xcc_id(); xb.st = xst;
  int ph = 0;
#define PHASE(...)                                               \
  {                                                              \
    if (ph >= pb && ph < pe) {                                   \
      __VA_ARGS__;                                               \
      if (ph + 1 < pe) { if (ph == 0) { grid.sync(); xb = xcd_barrier_post(p.bar, xst); } else { if (USE_XCD_BAR) xcd_barrier(xb); else grid.sync(); } } \
    }                                                            \
    ++ph;                                                        \
  }
  PHASE(if (blockIdx.x == 0) { for (int i = threadIdx.x; i < XCD_BAR_WORDS; i += NT) p.bar[i] = 0u; }
        phase_prep(p); phase_hb(p, 0); if (PROBE == 5) { phase_prep(p); } if (PROBE == 6) { phase_hb(p, 0); phase_hb(p, 0); })
  PHASE(phase_inproj(p, 0, smem); if (PROBE == 1) phase_inproj(p, 0, smem);)
#pragma unroll
  for (int g = 0; g < 2; ++g) {
    const float* xg = g ? p.x_sample : p.x_prompt;
    PHASE(conv_part(p, g); phase_local(p, g, smem);)
    PHASE(phase_scan(p, g);)
#if PROBE == 2
    PHASE(conv_part(p, g); phase_local(p, g, smem);)
    PHASE(phase_scan(p, g);)
#endif
    PHASE(phase_mlout(p, g, smem); if (PROBE == 2) phase_mlout(p, g, smem);)
    PHASE(phase_resid_gemm<true>(p, g, p.buf67, p.Wt_out, xg, p.ss1, p.xb, 1024, smem); if (PROBE == 1) phase_resid_gemm<true>(p, g, p.buf67, p.Wt_out, xg, p.gatew, p.xb, 1024, smem);)
    PHASE(phase_proj(p, g, p.xb, 1024, p.Wt_q, 1024, p.ss1, p.Qb, smem); if (g == 0) phase_hb(p, 1);)
    PHASE(phase_xattn(p, g, smem); if (PROBE == 3) phase_xattn(p, g, smem);)
    PHASE(phase_resid_gemm<false>(p, g, p.Ob, p.Wt_o, nullptr, p.ss2, (us*)(p.out + (size_t)g * TG * 1024), 2048, smem);)
    PHASE(phase_proj(p, g, (const us*)(p.out + (size_t)g * TG * 1024), 2048, p.Wt_pq, 2048, p.ss2, p.pq, smem);)
    PHASE(phase_topk(p, g, smem); if (PROBE == 3) phase_topk(p, g, smem);)
    PHASE(phase_gather(p, g, smem); if (g == 0) { __syncthreads(); phase_inproj(p, 1, smem); if (PROBE == 1) phase_inproj(p, 1, smem); })
  }
}

static int count_phases() { return 2 + 2 * (10 + (PROBE == 2 ? 2 : 0)); }

extern "C" void kernel_launch(void* const* d_in, const int* in_sizes, int n_in, void* d_out, int out_size, void* d_ws,
                              size_t ws_size, hipStream_t stream) {
  static int grid_blocks = 0;
  if (!grid_blocks) {
    hipFuncSetAttribute((const void*)mega, hipFuncAttributeMaxDynamicSharedMemorySize, LDS_BYTES);
    int dev = 0, cus = 0, per_cu = 0;
    hipGetDevice(&dev);
    hipDeviceGetAttribute(&cus, hipDeviceAttributeMultiprocessorCount, dev);
    hipOccupancyMaxActiveBlocksPerMultiprocessor(&per_cu, mega, NT, LDS_BYTES);
    if (per_cu < 1) per_cu = 1;
    if (per_cu > 1) per_cu = 1;
    grid_blocks = cus * per_cu;
  }
  Params p{};
  const float* const* in = (const float* const*)d_in;
  p.x_prompt = in[0]; p.x_sample = in[1]; p.mem_prompt = in[2]; p.mem_sample = in[3]; p.norm_mix_w = in[4]; p.w_in = in[5];
  p.gate_b = in[6]; p.conv_w = in[7]; p.conv_b = in[8]; p.mlstm_norm_w = in[9]; p.w_out = in[10]; p.norm_xattn_w = in[11];
  p.norm_mem_w = in[12]; p.xa_wq = in[13]; p.xa_wk = in[14]; p.xa_wv = in[15]; p.xa_wo = in[16]; p.norm_ffn_w = in[17];
  p.peer_wq = in[18]; p.peer_keys1 = in[19]; p.peer_keys2 = in[20]; p.peer_u = in[21]; p.peer_v = in[22]; p.norm_final_w = in[23];
  p.out = (float*)d_out;
  char* w = (char*)d_ws;
  size_t off = 0;
  auto take = [&](size_t bytes) { char* r = w + off; off += (bytes + 255) & ~(size_t)255; return r; };
  p.Wt_in = (us*)take((size_t)NIN_PAD * 1024 * 2);
  p.Wt_out = (us*)take(1024 * 1024 * 2);
  p.Wt_q = (us*)take(1024 * 1024 * 2);
  p.Wt_k = (us*)take(1024 * 1024 * 2);
  p.Wt_v = (us*)take(1024 * 1024 * 2);
  p.Wt_o = (us*)take(1024 * 1024 * 2);
  p.Wt_pq = (us*)take(2048 * 1024 * 2);
  p.keys1b = (us*)take(8 * 128 * 128 * 2);
  p.keys2b = (us*)take(8 * 128 * 128 * 2);
  p.Ub = (us*)take((size_t)16384 * 1024 * 2);
  p.Vb = (us*)take((size_t)16384 * 1024 * 2);
  p.memn = (us*)take(3072 * 1024 * 2);
  p.Kmem = (us*)take(3072 * 1024 * 2);
  p.VmemT = (us*)take(3072 * 1024 * 2);
  p.ss1 = (float*)take(65536 * 4);
  p.ss2 = (float*)take(65536 * 4);
  char* zbase = take((size_t)TG * ZW * 2);
  p.z = (us*)zbase;
  p.gates = (float*)take((size_t)TG * 16 * 4);
  char* stbase = take((size_t)2048 * 16384 * 2);
  p.states = (us*)stbase;
  p.nstate = (float*)take(2048 * 128 * 4);
  p.nprev = (float*)take(2048 * 128 * 4);
  p.scstate = (float*)take(2048 * 2 * 4);
  p.mprev = (float*)take(2048 * 4);
  p.buf67 = (us*)take((size_t)TG * 1024 * 2);
  p.bar = (unsigned*)take(XCD_BAR_WORDS * 4);
  p.xb = (us*)zbase;
  p.Qb = (us*)(zbase + (size_t)TG * 1024 * 2);
  p.Ob = (us*)(zbase + (size_t)TG * 1024 * 4);
  p.pq = (us*)(zbase + (size_t)TG * 1024 * 2);
  p.eidx = (int*)stbase;
  p.gatew = (float*)(stbase + (size_t)TG * 128 * 4);
  if (off > ws_size) fprintf(stderr, "workspace too small: need %zu have %zu\n", off, ws_size);
  const int nph = count_phases();
#if USE_COOP
  int pb = 0, pe = nph;
  void* args[] = {&p, &pb, &pe};
  hipError_t e = hipLaunchCooperativeKernel((void*)mega, dim3(grid_blocks), dim3(NT), args, LDS_BYTES, stream);
  if (e != hipSuccess) fprintf(stderr, "cooperative launch failed: %s (grid %d)\n", hipGetErrorString(e), grid_blocks);
#else
  for (int i = 0; i < nph; ++i) mega<<<grid_blocks, NT, LDS_BYTES, stream>>>(p, i, i + 1);
#endif
}
```

```cpp
#include <hip/hip_runtime.h>
#include <hip/hip_cooperative_groups.h>
#include <cstdio>
namespace cg = cooperative_groups;

#ifndef STAGE
#define STAGE 4
#endif
#ifndef PROBE
#define PROBE 0
#endif
#ifndef USE_XCD_BAR
#define USE_XCD_BAR 1
#endif
#ifndef USE_COOP
#define USE_COOP 1
#endif

#define DEVI __device__ __forceinline__
typedef unsigned short us;
typedef unsigned int u32;
using bf16x8 = __attribute__((ext_vector_type(8))) short;
using f32x4  = __attribute__((ext_vector_type(4))) float;

constexpr int TG = 32768;
constexpr int ZW = 3584;
constexpr int NIN_PAD = 3712;
constexpr float EPS = 1e-6f;
constexpr int LDS_BYTES = 151552;
constexpr int NT = 512;
constexpr float QS = 0.08838834764831845f;

struct Params {
  const float *x_prompt, *x_sample, *mem_prompt, *mem_sample, *norm_mix_w, *w_in, *gate_b, *conv_w, *conv_b,
      *mlstm_norm_w, *w_out, *norm_xattn_w, *norm_mem_w, *xa_wq, *xa_wk, *xa_wv, *xa_wo, *norm_ffn_w, *peer_wq,
      *peer_keys1, *peer_keys2, *peer_u, *peer_v, *norm_final_w;
  float* out;
  us *Wt_in, *Wt_out, *Wt_q, *Wt_k, *Wt_v, *Wt_o, *Wt_pq, *keys1b, *keys2b, *Ub, *Vb, *memn, *Kmem, *VmemT;
  float *ss1, *ss2;
  us* z; float* gates; us* states; float *nstate, *scstate, *nprev, *mprev; us* buf67;
  us *xb, *Qb, *Ob, *pq; int* eidx; float* gatew;
  unsigned* bar;
};

DEVI int opq(int x) { asm volatile("" : "+v"(x)); return x; }
DEVI us f2bf(float f) { u32 u = __float_as_uint(f); u += 0x7fffu + ((u >> 16) & 1u); return (us)(u >> 16); }
DEVI float bf2f(us h) { return __uint_as_float(((u32)h) << 16); }
DEVI u32 pack2(float a, float b) { return (u32)f2bf(a) | ((u32)f2bf(b) << 16); }
DEVI float bflo(u32 w) { return __uint_as_float(w << 16); }
DEVI float bfhi(u32 w) { return __uint_as_float(w & 0xffff0000u); }
DEVI float wave_sum(float v) {
#pragma unroll
  for (int o = 32; o >= 1; o >>= 1) v += __shfl_xor(v, o);
  return v;
}
DEVI float sigmoidf_(float x) { return __builtin_amdgcn_rcpf(1.f + __expf(-x)); }
DEVI float logsigf_(float x) { return fminf(x, 0.f) - log1pf(__expf(-fabsf(x))); }
DEVI float gelu_tanh(float x) {
  float y = 0.7978845608028654f * (x + 0.044715f * x * x * x);
  float t = 1.f - 2.f * __builtin_amdgcn_rcpf(__expf(2.f * y) + 1.f);
  return 0.5f * x * (1.f + t);
}
using i64x2 = __attribute__((ext_vector_type(2))) long;
DEVI u32 pack4_fp8(float a, float b, float c, float d) {
  int r = 0;
  r = __builtin_amdgcn_cvt_pk_fp8_f32(a, b, r, false);
  r = __builtin_amdgcn_cvt_pk_fp8_f32(c, d, r, true);
  return (u32)r;
}
DEVI u32 ordf(float f) { u32 u = __float_as_uint(f); return u ^ ((u >> 31) ? 0xFFFFFFFFu : 0x80000000u); }
DEVI float unordf(u32 o) { u32 u = (o & 0x80000000u) ? (o ^ 0x80000000u) : ~o; return __uint_as_float(u); }

#define WAIT_V0() asm volatile("s_waitcnt vmcnt(0)" ::: "memory")
template <int BM, int BN, int WM, int WN, bool ALDS, bool PRE = false>
DEVI void gemm_core(const us* A, int lda, const us* __restrict__ Bt, int ldb, int K, char* stage,
                    f32x4 (&acc)[BM / 16 / WM][BN / 16 / WN]) {
  constexpr int MI = BM / 16 / WM, NI = BN / 16 / WN;
  constexpr int ABYTES = ALDS ? 0 : BM * 128;
  constexpr int SBYTES = ABYTES + BN * 128;
  const int tid = opq(threadIdx.x), lane = tid & 63, wid = tid >> 6;
  const int wr = wid / WN, wc = wid % WN;
  const int fr = lane & 15, fq = lane >> 4;
  const int sw = (fq ^ ((fr >> 2) & 3)) << 4;
  auto issue = [&](int buf, int k0) {
    char* SA = stage + buf * SBYTES;
    char* SB = SA + ABYTES;
    if (!ALDS) {
#pragma unroll
      for (int i = 0; i < BM / 64; ++i) {
        int c = tid + i * 512;
        int kh = c / (BM * 4), cc = c % (BM * 4);
        int r = cc >> 2;
        int ch = (cc & 3) ^ ((r >> 2) & 3);
        __builtin_amdgcn_global_load_lds((const u32*)(A + (size_t)r * lda + k0 + kh * 32 + ch * 8), (u32*)(SA + c * 16), 16, 0, 0);
      }
    }
#pragma unroll
    for (int i = 0; i < BN / 64; ++i) {
      int c = tid + i * 512;
      int kh = c / (BN * 4), cc = c % (BN * 4);
      int r = cc >> 2;
      int ch = (cc & 3) ^ ((r >> 2) & 3);
      __builtin_amdgcn_global_load_lds((const u32*)(Bt + (size_t)r * ldb + k0 + kh * 32 + ch * 8), (u32*)(SB + c * 16), 16, 0, 0);
    }
  };
  const int nt = K >> 6;
  if (!PRE) issue(0, 0);
  WAIT_V0();
  __syncthreads();
#pragma unroll 1
  for (int t = 0; t < nt; ++t) {
    const int cur = t & 1;
    if (t + 1 < nt) issue(cur ^ 1, (t + 1) * 64);
    const char* SA = stage + cur * SBYTES;
    const char* SB = SA + ABYTES;
#pragma unroll
    for (int kh = 0; kh < 2; ++kh) {
      bf16x8 a[MI], b[NI];
#pragma unroll
      for (int m = 0; m < MI; ++m) {
        if (ALDS) a[m] = *(const bf16x8*)(A + (wr * (MI * 16) + m * 16 + fr) * lda + t * 64 + kh * 32 + fq * 8);
        else a[m] = *(const bf16x8*)(SA + kh * (BM * 64) + (wr * (MI * 16) + m * 16 + fr) * 64 + sw);
      }
#pragma unroll
      for (int n = 0; n < NI; ++n) b[n] = *(const bf16x8*)(SB + kh * (BN * 64) + (wc * (NI * 16) + n * 16 + fr) * 64 + sw);
      __builtin_amdgcn_sched_barrier(0);
#pragma unroll
      for (int m = 0; m < MI; ++m)
#pragma unroll
        for (int n = 0; n < NI; ++n) acc[m][n] = __builtin_amdgcn_mfma_f32_16x16x32_bf16(b[n], a[m], acc[m][n], 0, 0, 0);
      __builtin_amdgcn_sched_barrier(0);
    }
    WAIT_V0();
    __syncthreads();
  }
}


template <int BM, int BN, bool ALDS>
DEVI void gemm_issue0(const us* A, int lda, const us* __restrict__ Bt, int ldb, char* stage) {
  constexpr int ABYTES = ALDS ? 0 : BM * 128;
  const int tid = opq(threadIdx.x);
  if (!ALDS) {
#pragma unroll
    for (int i = 0; i < BM / 64; ++i) {
      int c = tid + i * 512;
      int kh = c / (BM * 4), cc = c % (BM * 4);
      int r = cc >> 2;
      int ch = (cc & 3) ^ ((r >> 2) & 3);
      __builtin_amdgcn_global_load_lds((const u32*)(A + (size_t)r * lda + kh * 32 + ch * 8), (u32*)(stage + c * 16), 16, 0, 0);
    }
  }
#pragma unroll
  for (int i = 0; i < BN / 64; ++i) {
    int c = tid + i * 512;
    int kh = c / (BN * 4), cc = c % (BN * 4);
    int r = cc >> 2;
    int ch = (cc & 3) ^ ((r >> 2) & 3);
    __builtin_amdgcn_global_load_lds((const u32*)(Bt + (size_t)r * ldb + kh * 32 + ch * 8), (u32*)(stage + ABYTES + c * 16), 16, 0, 0);
  }
}

namespace g8 {
#define G8_LAS __attribute__((address_space(3)))
constexpr int BM = 256, BK = 64, HALF = 128, HTB = HALF * BK * 2, NXCD = 8, WGM = 8;
DEVI int lds_byte(int r, int c) { const int st = (r >> 4) * 2 + (c >> 5), rr = r & 15, cc = c & 31, ob = rr * 64 + cc * 2; return st * 1024 + (ob ^ (((ob >> 9) & 1) << 5)); }
DEVI void stage_rc(int b, int& R, int& C) { const int st = b / 1024, sb = b % 1024, swz = sb ^ (((sb >> 9) & 1) << 5); R = (st >> 1) * 16 + swz / 64; C = (st & 1) * 32 + (swz % 64) / 2; }
DEVI int perm32(int rho) { const int n = rho >> 4, i = rho & 15; return 8 * (i >> 2) + 4 * n + (i & 3); }
struct Unit { int pm, pn; };
struct Order {
  int nM, nN, nwg, G, c;
  DEVI void init(int M, int N, int G_, int c_) { nM = M / BM; nN = N / BM; nwg = nM * nN; G = G_; c = c_; }
  DEVI bool next(int i, Unit& u) const {
    const long L = (long)i * G + c; if (L >= nwg) return false;
    int wgid = (int)L; { const int q = nwg / NXCD, r = nwg % NXCD, xcd = wgid % NXCD, off = wgid / NXCD; wgid = (xcd < r ? xcd * (q + 1) : r * (q + 1) + (xcd - r) * q) + off; }
    const int nig = WGM * nN, gid = wgid / nig, fm = gid * WGM, gsz = (nM - fm) < WGM ? (nM - fm) : WGM;
    u.pm = fm + ((wgid % nig) % gsz); u.pn = (wgid % nig) / gsz; return true;
  }
};
DEVI u32 cvt_pk_bf16(float lo, float hi) { u32 r; asm volatile("v_cvt_pk_bf16_f32 %0, %1, %2" : "=v"(r) : "v"(lo), "v"(hi)); return r; }

template <class Epi>
DEVI void gemm_phase(G8_LAS unsigned char* lds, const us* Ag, int lda, const us* Btg, int M, int N, int K, const Epi& E, int cshift = 0) {
  const int tid = opq(threadIdx.x), wid = __builtin_amdgcn_readfirstlane(tid >> 6), lane = tid & 63, wr = wid >> 2, wc = wid & 3, fr = lane & 15, fq = lane >> 4;
  const int nt = K / BK;
  Order S; S.init(M, N, gridDim.x, (int)((blockIdx.x + (unsigned)cshift) % gridDim.x));
  unsigned voffA[2], voffB[2];
#pragma unroll
  for (int i = 0; i < 2; ++i) { int R, C; stage_rc(tid * 16 + i * 8192, R, C); const int Rb = (R & ~31) + perm32(R & 31);
    voffA[i] = (unsigned)(R * lda + C) * 2u; voffB[i] = (unsigned)(Rb * K + C) * 2u; }
  const size_t kstep = (size_t)(BK * 2);
  const size_t hstep = (size_t)HALF * K * 2, hstepA = (size_t)HALF * lda * 2;
  const size_t tstep = 2 * hstep, tstepA = 2 * hstepA;
  const unsigned ldsw = (unsigned)wid * 1024u;
  const int aoff = lds_byte(wr * 64 + fr, fq * 8), boff = lds_byte(wc * 32 + fr, fq * 8);
#define G8_SA(b, h) (((b) * 2 + (h)) * HTB)
#define G8_SB(b, h) ((4 + (b) * 2 + (h)) * HTB)
#define G8_STAGE(bufoff, gbase, voff) do { _Pragma("unroll") for (int _i = 0; _i < 2; ++_i) \
    __builtin_amdgcn_global_load_lds((const unsigned*)((const char*)(gbase) + (voff)[_i]), (G8_LAS unsigned*)(lds + (bufoff) + ldsw + _i * 8192), 16, 0, 0); } while (0)
#define G8_LDA(dst, b, h) do { _Pragma("unroll") for (int m = 0; m < 4; ++m) _Pragma("unroll") for (int k = 0; k < 2; ++k) dst[m][k] = *(const G8_LAS bf16x8*)(lds + G8_SA(b, h) + aoff + m * 2048 + k * 1024); } while (0)
#define G8_LDB(dst, b, h) do { _Pragma("unroll") for (int n = 0; n < 2; ++n) _Pragma("unroll") for (int k = 0; k < 2; ++k) dst[n][k] = *(const G8_LAS bf16x8*)(lds + G8_SB(b, h) + boff + n * 2048 + k * 1024); } while (0)
#define G8_MMA(ai, bj, At, Bt) do { __builtin_amdgcn_s_setprio(1); _Pragma("unroll") for (int m = 0; m < 4; ++m) _Pragma("unroll") for (int n = 0; n < 2; ++n) _Pragma("unroll") for (int k = 0; k < 2; ++k) \
    acc[ai][bj][m][n] = __builtin_amdgcn_mfma_f32_16x16x32_bf16(Bt[n][k], At[m][k], acc[ai][bj][m][n], 0, 0, 0); __builtin_amdgcn_s_setprio(0); } while (0)
#define G8_WAIT_V(n) asm volatile("s_waitcnt vmcnt(" #n ")" ::: "memory")
#define G8_WAIT_L(n) asm volatile("s_waitcnt lgkmcnt(" #n ")" ::: "memory")
#define G8_BAR __builtin_amdgcn_s_barrier()
#define G8_SCHED __builtin_amdgcn_sched_barrier(0)
  Unit cur, nxt; int ui = 0;
  if (!S.next(0, cur)) return;
  f32x4 acc[2][2][4][2];
#pragma unroll
  for (int a = 0; a < 2; ++a)
#pragma unroll
    for (int b = 0; b < 2; ++b)
#pragma unroll
      for (int m = 0; m < 4; ++m)
#pragma unroll
        for (int n = 0; n < 2; ++n) acc[a][b][m][n] = (f32x4){0.f, 0.f, 0.f, 0.f};
  bf16x8 At[4][2], B0[2][2], B1[2][2];
  const char* cA = (const char*)Ag + (size_t)cur.pm * tstepA; const char* cB = (const char*)Btg + (size_t)cur.pn * tstep;
  G8_WAIT_V(0); G8_WAIT_L(0); G8_BAR;
  G8_STAGE(G8_SB(0, 0), cB, voffB); G8_STAGE(G8_SA(0, 0), cA, voffA); G8_STAGE(G8_SB(0, 1), cB + hstep, voffB); G8_STAGE(G8_SA(0, 1), cA + hstepA, voffA);
  if (wr == 1) G8_BAR;
  G8_WAIT_V(4); G8_BAR;
  G8_STAGE(G8_SB(1, 0), cB + kstep, voffB); G8_STAGE(G8_SA(1, 0), cA + kstep, voffA); G8_STAGE(G8_SB(1, 1), cB + hstep + kstep, voffB);
  G8_WAIT_V(6); G8_BAR;
  for (;;) {
    const bool has_next = S.next(ui + 1, nxt);
    const char* nA = has_next ? (const char*)Ag + (size_t)nxt.pm * tstepA : cA; const char* nB = has_next ? (const char*)Btg + (size_t)nxt.pn * tstep : cB;
    for (int t = 0; t < nt; t += 2) {
      const bool last = (t == nt - 2);
      const char* a1 = cA + (size_t)(t + 1) * kstep;
      const char* a2 = last ? nA : cA + (size_t)(t + 2) * kstep; const char* b2 = last ? nB : cB + (size_t)(t + 2) * kstep;
      const char* a3 = a2 + kstep; const char* b3 = b2 + kstep;
      G8_LDB(B0, 0, 0); G8_SCHED; G8_LDA(At, 0, 0); G8_STAGE(G8_SA(1, 1), a1 + hstepA, voffA);
      G8_WAIT_L(8); G8_BAR; G8_WAIT_L(0); G8_MMA(0, 0, At, B0); G8_BAR; G8_SCHED;
      G8_LDB(B1, 0, 1); G8_STAGE(G8_SB(0, 0), b2, voffB);
      G8_BAR; G8_WAIT_L(0); G8_MMA(0, 1, At, B1); G8_BAR;
      G8_LDA(At, 0, 1); G8_STAGE(G8_SA(0, 0), a2, voffA);
      G8_BAR; G8_WAIT_L(0); G8_MMA(1, 0, At, B0); G8_BAR; G8_SCHED;
      G8_STAGE(G8_SB(0, 1), b2 + hstep, voffB);
      G8_WAIT_V(6); G8_BAR; G8_MMA(1, 1, At, B1); G8_BAR;
      G8_LDB(B0, 1, 0); G8_SCHED; G8_LDA(At, 1, 0); G8_STAGE(G8_SA(0, 1), a2 + hstepA, voffA);
      G8_WAIT_L(8); G8_BAR; G8_WAIT_L(0); G8_MMA(0, 0, At, B0); G8_BAR; G8_SCHED;
      G8_LDB(B1, 1, 1); G8_STAGE(G8_SB(1, 0), b3, voffB);
      G8_BAR; G8_WAIT_L(0); G8_MMA(0, 1, At, B1); G8_BAR;
      G8_LDA(At, 1, 1); G8_STAGE(G8_SA(1, 0), a3, voffA);
      G8_BAR; G8_WAIT_L(0); G8_MMA(1, 0, At, B0); G8_BAR; G8_SCHED;
      G8_STAGE(G8_SB(1, 1), b3 + hstep, voffB);
      G8_WAIT_V(6); G8_BAR; G8_MMA(1, 1, At, B1); G8_BAR;
    }
    E(acc, cur, wr, wc, fr, fq);
    if (!has_next) break;
#pragma unroll
    for (int a = 0; a < 2; ++a)
#pragma unroll
      for (int b = 0; b < 2; ++b)
#pragma unroll
        for (int m = 0; m < 4; ++m)
#pragma unroll
          for (int n = 0; n < 2; ++n) acc[a][b][m][n] = (f32x4){0.f, 0.f, 0.f, 0.f};
    cur = nxt; cA = nA; cB = nB; ++ui;
  }
  G8_WAIT_V(0);
  if (wr == 0) G8_BAR;
  G8_BAR;
#undef G8_SA
#undef G8_SB
#undef G8_STAGE
#undef G8_LDA
#undef G8_LDB
#undef G8_MMA
#undef G8_WAIT_V
#undef G8_WAIT_L
#undef G8_BAR
#undef G8_SCHED
}

struct EpiStoreBf16 {
  us* O; int ldc;
  DEVI void operator()(const f32x4 (&acc)[2][2][4][2], const Unit& u, int wr, int wc, int fr, int fq) const {
    const int row0 = u.pm * BM + wr * 64 + fr, col0 = u.pn * BM + wc * 32 + 8 * fq;
#pragma unroll
    for (int ai = 0; ai < 2; ++ai)
#pragma unroll
      for (int m = 0; m < 4; ++m) {
        us* rowp = O + (size_t)(row0 + ai * HALF + m * 16) * ldc + col0;
#pragma unroll
        for (int bj = 0; bj < 2; ++bj) {
          const f32x4 v0 = acc[ai][bj][m][0], v1 = acc[ai][bj][m][1];
          *(uint4*)(rowp + bj * HALF) = make_uint4(cvt_pk_bf16(v0[0], v0[1]), cvt_pk_bf16(v0[2], v0[3]), cvt_pk_bf16(v1[0], v1[1]), cvt_pk_bf16(v1[2], v1[3]));
        }
      }
  }
};

template <bool XF32>
struct EpiResid {
  const float* xf; const us* xb; us* xout; int ldo; float* ss;
  DEVI void operator()(const f32x4 (&acc)[2][2][4][2], const Unit& u, int wr, int wc, int fr, int fq) const {
    const int row0 = u.pm * BM + wr * 64 + fr, col0 = u.pn * BM + wc * 32 + 8 * fq;
#pragma unroll
    for (int ai = 0; ai < 2; ++ai)
#pragma unroll
      for (int m = 0; m < 4; ++m) {
        const int row = row0 + ai * HALF + m * 16;
        float rsum = 0.f;
#pragma unroll
        for (int bj = 0; bj < 2; ++bj) {
          const int col = col0 + bj * HALF;
          float xo[8];
          if (XF32) {
            const float4 a = *(const float4*)(xf + (size_t)row * 1024 + col), b = *(const float4*)(xf + (size_t)row * 1024 + col + 4);
            xo[0] = a.x; xo[1] = a.y; xo[2] = a.z; xo[3] = a.w; xo[4] = b.x; xo[5] = b.y; xo[6] = b.z; xo[7] = b.w;
          } else {
            const uint4 a = *(const uint4*)(xb + (size_t)row * 1024 + col);
            xo[0] = bflo(a.x); xo[1] = bfhi(a.x); xo[2] = bflo(a.y); xo[3] = bfhi(a.y); xo[4] = bflo(a.z); xo[5] = bfhi(a.z); xo[6] = bflo(a.w); xo[7] = bfhi(a.w);
          }
          const f32x4 v0 = acc[ai][bj][m][0], v1 = acc[ai][bj][m][1];
          float xn[8] = {xo[0] + v0[0], xo[1] + v0[1], xo[2] + v0[2], xo[3] + v0[3], xo[4] + v1[0], xo[5] + v1[1], xo[6] + v1[2], xo[7] + v1[3]};
          *(uint4*)(xout + (size_t)row * ldo + col) = make_uint4(cvt_pk_bf16(xn[0], xn[1]), cvt_pk_bf16(xn[2], xn[3]), cvt_pk_bf16(xn[4], xn[5]), cvt_pk_bf16(xn[6], xn[7]));
#pragma unroll
          for (int e = 0; e < 8; ++e) rsum += xn[e] * xn[e];
        }
        rsum += __shfl_xor(rsum, 16); rsum += __shfl_xor(rsum, 32);
        if (fq == 0) atomicAdd(ss + row, rsum);
      }
  }
};

struct EpiScaleBf16 {
  us* O; int ldc; const float* ss;
  DEVI void operator()(const f32x4 (&acc)[2][2][4][2], const Unit& u, int wr, int wc, int fr, int fq) const {
    const int row0 = u.pm * BM + wr * 64 + fr, col0 = u.pn * BM + wc * 32 + 8 * fq;
#pragma unroll
    for (int ai = 0; ai < 2; ++ai)
#pragma unroll
      for (int m = 0; m < 4; ++m) {
        const int row = row0 + ai * HALF + m * 16;
        const float rs = rsqrtf(ss[row] * (1.f / 1024.f) + EPS);
        us* rowp = O + (size_t)row * ldc + col0;
#pragma unroll
        for (int bj = 0; bj < 2; ++bj) {
          const f32x4 v0 = acc[ai][bj][m][0] * rs, v1 = acc[ai][bj][m][1] * rs;
          *(uint4*)(rowp + bj * HALF) = make_uint4(cvt_pk_bf16(v0[0], v0[1]), cvt_pk_bf16(v0[2], v0[3]), cvt_pk_bf16(v1[0], v1[1]), cvt_pk_bf16(v1[2], v1[3]));
        }
      }
  }
};
}

template <int BM, int WM, int WN>
DEVI void mma_lds(const us* sA, int lda, const us* sB, int ldb, int K, f32x4 (&acc)[BM / 16 / WM][8 / WN]) {
  constexpr int MI = BM / 16 / WM, NI = 8 / WN;
  const int tid = opq(threadIdx.x), lane = tid & 63, wid = tid >> 6;
  const int wr = wid / WN, wc = wid % WN;
  const int fr = lane & 15, fq = lane >> 4;
#pragma unroll 1
  for (int k0 = 0; k0 < K; k0 += 32) {
    bf16x8 a[MI], b[NI];
#pragma unroll
    for (int m = 0; m < MI; ++m) a[m] = *(const bf16x8*)(sA + (wr * (MI * 16) + m * 16 + fr) * lda + k0 + fq * 8);
#pragma unroll
    for (int n = 0; n < NI; ++n) b[n] = *(const bf16x8*)(sB + (wc * (NI * 16) + n * 16 + fr) * ldb + k0 + fq * 8);
#pragma unroll
    for (int m = 0; m < MI; ++m)
#pragma unroll
      for (int n = 0; n < NI; ++n) acc[m][n] = __builtin_amdgcn_mfma_f32_16x16x32_bf16(b[n], a[m], acc[m][n], 0, 0, 0);
  }
}

template <int MI, int NI>
DEVI void zero_acc(f32x4 (&acc)[MI][NI]) {
#pragma unroll
  for (int m = 0; m < MI; ++m)
#pragma unroll
    for (int n = 0; n < NI; ++n) acc[m][n] = f32x4{0.f, 0.f, 0.f, 0.f};
}

DEVI void transpose_w(const float* __restrict__ W, int K, int N, us* __restrict__ Wt, int Npad,
                      const float* __restrict__ rs, int gtid, int gsz) {
  int items = Npad * (K / 8);
  for (int it = gtid; it < items; it += gsz) {
    int n = it % Npad, k8 = it / Npad;
    u32 o[4];
#pragma unroll
    for (int i = 0; i < 4; ++i) {
      int k = k8 * 8 + 2 * i;
      float a = 0.f, b = 0.f;
      if (n < N) {
        a = W[(size_t)k * N + n];
        b = W[(size_t)(k + 1) * N + n];
        if (rs) { a *= rs[k]; b *= rs[k + 1]; }
      }
      o[i] = pack2(a, b);
    }
    *(uint4*)(Wt + (size_t)n * K + k8 * 8) = make_uint4(o[0], o[1], o[2], o[3]);
  }
}

DEVI void cvt_bf16(const float* __restrict__ src, us* __restrict__ dst, size_t n8, int gtid, int gsz) {
  for (size_t i = gtid; i < n8; i += gsz) {
    float4 a = ((const float4*)src)[2 * i], b = ((const float4*)src)[2 * i + 1];
    ((uint4*)dst)[i] = make_uint4(pack2(a.x, a.y), pack2(a.z, a.w), pack2(b.x, b.y), pack2(b.z, b.w));
  }
}

DEVI void cvt_fp8(const float* __restrict__ src, unsigned char* __restrict__ dst, size_t n16, float scale, int gtid, int gsz) {
  for (size_t i = gtid; i < n16; i += gsz) {
    float4 a = ((const float4*)src)[4 * i], b = ((const float4*)src)[4 * i + 1], c = ((const float4*)src)[4 * i + 2], d = ((const float4*)src)[4 * i + 3];
    ((uint4*)dst)[i] = make_uint4(pack4_fp8(a.x * scale, a.y * scale, a.z * scale, a.w * scale), pack4_fp8(b.x * scale, b.y * scale, b.z * scale, b.w * scale),
                                  pack4_fp8(c.x * scale, c.y * scale, c.z * scale, c.w * scale), pack4_fp8(d.x * scale, d.y * scale, d.z * scale, d.w * scale));
  }
}


typedef int v6i __attribute__((ext_vector_type(6)));
typedef int v8i __attribute__((ext_vector_type(8)));
typedef float v32f __attribute__((ext_vector_type(32)));
typedef float v2f __attribute__((ext_vector_type(2)));
typedef __bf16 v32bf __attribute__((ext_vector_type(32)));
typedef short v32s __attribute__((ext_vector_type(32)));
DEVI u32 fp6_code(float x) {
  float a = fminf(fabsf(x), 7.5f);
  float c;
  if (a < 2.f) c = rintf(a * 8.f);
  else if (a < 4.f) c = 16.f + rintf((a - 2.f) * 4.f);
  else c = 24.f + rintf((a - 4.f) * 2.f);
  u32 ci = (u32)c;
  ci = ci > 31u ? 31u : ci;
  return ci | ((x < 0.f) ? 32u : 0u);
}
DEVI void cvt_fp6(const float* __restrict__ src, unsigned char* __restrict__ dst, size_t n32, float scale, int gtid, int gsz) {
  for (size_t i = gtid; i < n32; i += gsz) {
    const float4* sp = (const float4*)(src + i * 32);
    u32 out[6];
    unsigned long long accb = 0ull;
    int nb = 0, k = 0;
#pragma unroll
    for (int j = 0; j < 8; ++j) {
      float4 f = sp[j];
      float e[4] = {f.x, f.y, f.z, f.w};
#pragma unroll
      for (int t = 0; t < 4; ++t) {
        accb |= (unsigned long long)fp6_code(e[t] * scale) << nb;
        nb += 6;
        if (nb >= 32) { out[k++] = (u32)accb; accb >>= 32; nb -= 32; }
      }
    }
    uint2* dp = (uint2*)(dst + i * 24);
    dp[0] = make_uint2(out[0], out[1]); dp[1] = make_uint2(out[2], out[3]); dp[2] = make_uint2(out[4], out[5]);
  }
}


DEVI u32 fp4_code(float x) {
  const float a = fabsf(x);
  u32 c = (a < 0.25f) ? 0u : (a < 0.75f) ? 1u : (a < 1.25f) ? 2u : (a < 1.75f) ? 3u : (a < 2.5f) ? 4u : (a < 3.5f) ? 5u : (a < 5.f) ? 6u : 7u;
  return c | ((x < 0.f) ? 8u : 0u);
}
DEVI void cvt_fp4(const float* __restrict__ src, unsigned char* __restrict__ dst, size_t n32, float scale, int gtid, int gsz) {
  for (size_t i = gtid; i < n32; i += gsz) {
    const float4* sp = (const float4*)(src + i * 32);
    u32 out[4];
#pragma unroll
    for (int d = 0; d < 4; ++d) {
      float4 f0 = sp[2 * d], f1 = sp[2 * d + 1];
      out[d] = fp4_code(f0.x * scale) | (fp4_code(f0.y * scale) << 4) | (fp4_code(f0.z * scale) << 8) | (fp4_code(f0.w * scale) << 12) |
               (fp4_code(f1.x * scale) << 16) | (fp4_code(f1.y * scale) << 20) | (fp4_code(f1.z * scale) << 24) | (fp4_code(f1.w * scale) << 28);
    }
    ((uint4*)dst)[i] = make_uint4(out[0], out[1], out[2], out[3]);
  }
}

DEVI void rms_row_bf16(const float* __restrict__ xrow, const float* __restrict__ w, us* __restrict__ orow, int lane) {
  float4 v[4];
  float ss = 0.f;
#pragma unroll
  for (int i = 0; i < 4; ++i) {
    v[i] = ((const float4*)xrow)[i * 64 + lane];
    ss += v[i].x * v[i].x + v[i].y * v[i].y + v[i].z * v[i].z + v[i].w * v[i].w;
  }
  ss = wave_sum(ss);
  float rs = rsqrtf(ss * (1.f / 1024.f) + EPS);
#pragma unroll
  for (int i = 0; i < 4; ++i) {
    float4 ww = ((const float4*)w)[i * 64 + lane];
    ((uint2*)orow)[i * 64 + lane] = make_uint2(pack2(v[i].x * rs * ww.x, v[i].y * rs * ww.y), pack2(v[i].z * rs * ww.z, v[i].w * rs * ww.w));
  }
}

DEVI void phase_prep(const Params& p) {
  const int gtid = blockIdx.x * NT + opq(threadIdx.x), gsz = gridDim.x * NT;
  transpose_w(p.w_in, 1024, 3600, p.Wt_in, NIN_PAD, nullptr, gtid, gsz);
  transpose_w(p.w_out, 1024, 1024, p.Wt_out, 1024, nullptr, gtid, gsz);
  transpose_w(p.xa_wq, 1024, 1024, p.Wt_q, 1024, p.norm_xattn_w, gtid, gsz);
  transpose_w(p.xa_wk, 1024, 1024, p.Wt_k, 1024, nullptr, gtid, gsz);
  transpose_w(p.xa_wv, 1024, 1024, p.Wt_v, 1024, nullptr, gtid, gsz);
  transpose_w(p.xa_wo, 1024, 1024, p.Wt_o, 1024, nullptr, gtid, gsz);
  transpose_w(p.peer_wq, 1024, 2048, p.Wt_pq, 2048, p.norm_ffn_w, gtid, gsz);
  cvt_bf16(p.peer_keys1, p.keys1b, 8 * 128 * 128 / 8, gtid, gsz);
  cvt_bf16(p.peer_keys2, p.keys2b, 8 * 128 * 128 / 8, gtid, gsz);
  cvt_fp6(p.peer_u, (unsigned char*)p.Ub, (size_t)16384 * 1024 / 32, 64.f, gtid, gsz);
  cvt_fp4(p.peer_v, (unsigned char*)p.Vb, (size_t)16384 * 1024 / 32, 16.f, gtid, gsz);
  for (int i = gtid; i < 65536; i += gsz) { p.ss1[i] = 0.f; p.ss2[i] = 0.f; }
  const int gw = gtid >> 6, nw = gsz >> 6, lane = gtid & 63;
  for (int r = gw; r < 3072; r += nw) {
    const float* src = r < 2048 ? p.mem_prompt + (size_t)r * 1024 : p.mem_sample + (size_t)(r - 2048) * 1024;
    rms_row_bf16(src, p.norm_mem_w, p.memn + (size_t)r * 1024, lane);
  }
}

DEVI void phase_hb(const Params& p, int g) {
  const int gtid = blockIdx.x * NT + opq(threadIdx.x), gsz = gridDim.x * NT;
  const int gw = gtid >> 6, nw = gsz >> 6, lane = gtid & 63;
  const float* x = g ? p.x_sample : p.x_prompt;
  for (int r = gw; r < TG; r += nw) rms_row_bf16(x + (size_t)r * 1024, p.norm_mix_w, p.buf67 + (size_t)r * 1024, lane);
}


DEVI bool xcd_tile(int it, int TN, int& tm, int& tn) {
  const int x = blockIdx.x & 7, lb = blockIdx.x >> 3, nlb = gridDim.x >> 3;
  const int lt = lb + it * nlb;
  if (lb >= nlb || lt >= 16 * TN) return false;
  tn = (lt >> 2) % TN;
  tm = x * 16 + (lt / (4 * TN)) * 4 + (lt & 3);
  return true;
}

template <class F>
DEVI void epi256(const f32x4 (&acc)[8][4], int row0, int col0, F f) {
  const int tid_ = opq(threadIdx.x);
  const int lane = tid_ & 63, wid = tid_ >> 6, wr = wid >> 2, wc = wid & 3, fr = lane & 15, fq = lane >> 4;
#pragma unroll
  for (int m = 0; m < 8; ++m)
#pragma unroll
    for (int n = 0; n < 4; ++n) f(row0 + wr * 128 + m * 16 + fr, col0 + wc * 64 + n * 16 + fq * 4, acc[m][n]);
}

DEVI void phase_inproj(const Params& p, int g, char* smem) {
  {
    g8::EpiStoreBf16 E{p.z, ZW};
    g8::gemm_phase((G8_LAS unsigned char*)smem, p.buf67, 1024, p.Wt_in, TG, ZW, 1024, E);
  }
  if (g == 0) {
    const int G = gridDim.x;
    g8::EpiStoreBf16 EK{p.Kmem, 1024};
    g8::gemm_phase((G8_LAS unsigned char*)smem, p.memn, 1024, p.Wt_k, 3072, 1024, 1024, EK, 0);
    g8::EpiStoreBf16 EV{p.VmemT, 3072};
    g8::gemm_phase((G8_LAS unsigned char*)smem, p.Wt_v, 1024, p.memn, 1024, 3072, 1024, EV, G > 48 ? G - 48 : 0);
  }
  {
    const int tid_ = opq(threadIdx.x);
    const int lane = tid_ & 63, wid = tid_ >> 6, fr = lane & 15, fq = lane >> 4;
    const int half = gridDim.x >> 1;
    for (int tile = (int)((blockIdx.x + half) % gridDim.x); tile < 128; tile += gridDim.x) {
      const int row0 = tile * 256 + wid * 32;
      const us* A0 = p.buf67 + (size_t)(row0 + fr) * 1024 + fq * 8;
      const us* B0 = p.Wt_in + (size_t)(ZW + fr) * 1024 + fq * 8;
      f32x4 acc0 = {0.f, 0.f, 0.f, 0.f}, acc1 = {0.f, 0.f, 0.f, 0.f};
#pragma unroll 8
      for (int k = 0; k < 32; ++k) {
        const bf16x8 bw = *(const bf16x8*)(B0 + k * 32);
        const bf16x8 a0 = *(const bf16x8*)(A0 + k * 32), a1 = *(const bf16x8*)(A0 + 16 * 1024 + k * 32);
        acc0 = __builtin_amdgcn_mfma_f32_16x16x32_bf16(bw, a0, acc0, 0, 0, 0);
        acc1 = __builtin_amdgcn_mfma_f32_16x16x32_bf16(bw, a1, acc1, 0, 0, 0);
      }
      const float4 gb = *(const float4*)(p.gate_b + fq * 4);
      *(float4*)(p.gates + (size_t)(row0 + fr) * 16 + fq * 4) = make_float4(acc0[0] + gb.x, acc0[1] + gb.y, acc0[2] + gb.z, acc0[3] + gb.w);
      *(float4*)(p.gates + (size_t)(row0 + 16 + fr) * 16 + fq * 4) = make_float4(acc1[0] + gb.x, acc1[1] + gb.y, acc1[2] + gb.z, acc1[3] + gb.w);
    }
  }
}

DEVI float scan128_sum(float v, float* tmp) {
  const int tid_ = opq(threadIdx.x); const int lane = tid_ & 63, wid = tid_ >> 6;
#pragma unroll
  for (int o = 1; o < 64; o <<= 1) { float t = __shfl_up(v, o); if (lane >= o) v += t; }
  if (lane == 63) tmp[wid] = v;
  __syncthreads();
  if (wid == 1) v += tmp[0];
  __syncthreads();
  return v;
}
DEVI float scan128_max(float v, float* tmp) {
  const int tid_ = opq(threadIdx.x); const int lane = tid_ & 63, wid = tid_ >> 6;
#pragma unroll
  for (int o = 1; o < 64; o <<= 1) { float t = __shfl_up(v, o); if (lane >= o) v = fmaxf(v, t); }
  if (lane == 63) tmp[wid] = v;
  __syncthreads();
  if (wid == 1) v = fmaxf(v, tmp[0]);
  __syncthreads();
  return v;
}

DEVI void conv_part(const Params& p, int g) {
  const int gtid = blockIdx.x * NT + opq(threadIdx.x), gsz = gridDim.x * NT;
  const int seqmask = g ? 8191 : 4095;
  for (int idx = gtid; idx < TG * 64; idx += gsz) {
    int t = idx >> 6, c8 = idx & 63;
    int pos = t & seqmask;
    const us* zr = p.z + (size_t)t * ZW + c8 * 8;
    uint4 xt1 = *(const uint4*)(zr), bg1 = *(const uint4*)(zr + 512), cg1 = *(const uint4*)(zr + 1024);
    uint4 xt0 = make_uint4(0, 0, 0, 0), cg0 = xt0, xt2 = xt0, cg2 = xt0;
    if (pos > 0) { xt0 = *(const uint4*)(zr - ZW); cg0 = *(const uint4*)(zr - ZW + 1024); }
    if (pos < seqmask) { xt2 = *(const uint4*)(zr + ZW); cg2 = *(const uint4*)(zr + ZW + 1024); }
    const u32* a0 = (const u32*)&xt0; const u32* b0 = (const u32*)&cg0;
    const u32* a1 = (const u32*)&xt1; const u32* b1 = (const u32*)&cg1;
    const u32* a2 = (const u32*)&xt2; const u32* b2 = (const u32*)&cg2;
    const u32* gg = (const u32*)&bg1;
    u32 o[4];
#pragma unroll
    for (int i = 0; i < 4; ++i) {
      int c = c8 * 8 + 2 * i;
      float u0l = bflo(a0[i]) * bflo(b0[i]), u0h = bfhi(a0[i]) * bfhi(b0[i]);
      float u1l = bflo(a1[i]) * bflo(b1[i]), u1h = bfhi(a1[i]) * bfhi(b1[i]);
      float u2l = bflo(a2[i]) * bflo(b2[i]), u2h = bfhi(a2[i]) * bfhi(b2[i]);
      float cl = p.conv_w[c] * u0l + p.conv_w[512 + c] * u1l + p.conv_w[1024 + c] * u2l + p.conv_b[c];
      float ch = p.conv_w[c + 1] * u0h + p.conv_w[512 + c + 1] * u1h + p.conv_w[1024 + c + 1] * u2h + p.conv_b[c + 1];
      o[i] = pack2(bflo(gg[i]) * cl, bfhi(gg[i]) * ch);
    }
    *(uint4*)(p.buf67 + (size_t)t * 1024 + c8 * 8) = make_uint4(o[0], o[1], o[2], o[3]);
#if STAGE < 2
    *(uint4*)(p.buf67 + (size_t)t * 1024 + 512 + c8 * 8) = make_uint4(0, 0, 0, 0);
#endif
  }
}

DEVI void phase_local(const Params& p, int g, char* smem) {
  const int tid = opq(threadIdx.x), lane = tid & 63, wid = tid >> 6, wr = wid >> 1, wc = wid & 1, fr = lane & 15, fq = lane >> 4;
  us* VT = (us*)smem;
  us* KF = VT + 128 * 72;
  us* KB = KF + 128 * 72;
  float* scl = (float*)(KB + 128 * 72);
  float* tmp = scl + 256;
  for (int unit = blockIdx.x; unit < 1024; unit += gridDim.x) {
    const int cl = unit >> 2, h = unit & 3, t0 = cl * 128;
    __syncthreads();
#pragma unroll
    for (int d = 0; d < 2; ++d) {
      int l = d ? 127 - (tid & 127) : (tid & 127);
      const float* gr = p.gates + (size_t)(t0 + l) * 16;
      float ig = gr[d * 4 + h], fg = gr[8 + d * 4 + h];
      float a = scan128_sum(logsigf_(fg), tmp);
      if (tid == 127) tmp[16] = a;
      __syncthreads();
      float gtot = tmp[16];
      float w = gtot - a + ig;
      float wm = w;
#pragma unroll
      for (int o = 32; o >= 1; o >>= 1) wm = fmaxf(wm, __shfl_xor(wm, o));
      if (lane == 0) tmp[8 + wid] = wm;
      __syncthreads();
      float mloc = fmaxf(tmp[8], tmp[9]);
      if (tid < 128) scl[d * 128 + l] = __expf(w - mloc);
      if (tid == 0) { p.scstate[(unit * 2 + d) * 2] = gtot; p.scstate[(unit * 2 + d) * 2 + 1] = mloc; }
      __syncthreads();
    }
    f32x4 accF[2][4], accB[2][4];
    zero_acc(accF);
    zero_acc(accB);
    float nsum = 0.f;
    for (int lh = 0; lh < 2; ++lh) {
      __syncthreads();
      for (int idx = tid; idx < 1024; idx += NT) {
        int lrow = idx & 63, c8 = idx >> 6;
        int l = lh * 64 + lrow;
        const us* zr = p.z + (size_t)(t0 + l) * ZW + h * 128 + c8 * 8;
        uint4 kv = *(const uint4*)(zr + 2048), vv = *(const uint4*)(zr + 2560);
        float sf = scl[l], sb = scl[128 + l];
        const u32* kw = (const u32*)&kv; const u32* vw = (const u32*)&vv;
#pragma unroll
        for (int i = 0; i < 4; ++i) {
          int r0 = (c8 * 8 + 2 * i) * 72 + lrow, r1 = r0 + 72;
          float k0 = bflo(kw[i]), k1 = bfhi(kw[i]);
          KF[r0] = f2bf(k0 * sf); KF[r1] = f2bf(k1 * sf);
          KB[r0] = f2bf(k0 * sb); KB[r1] = f2bf(k1 * sb);
          VT[r0] = (us)(vw[i] & 0xffffu); VT[r1] = (us)(vw[i] >> 16);
        }
      }
      __syncthreads();
      mma_lds<128, 4, 2>(VT, 72, KF, 72, 64, accF);
      mma_lds<128, 4, 2>(VT, 72, KB, 72, 64, accB);
      if (tid < 256) {
        const us* kr = (tid < 128 ? KF : KB) + (tid & 127) * 72;
#pragma unroll
        for (int i = 0; i < 8; ++i) {
          uint4 q = *(const uint4*)(kr + i * 8);
          nsum += bflo(q.x) + bfhi(q.x) + bflo(q.y) + bfhi(q.y) + bflo(q.z) + bfhi(q.z) + bflo(q.w) + bfhi(q.w);
        }
      }
    }
    if (tid < 256) p.nstate[(size_t)(unit * 2 + (tid >> 7)) * 128 + (tid & 127)] = nsum;
    us* cf = p.states + (size_t)(unit * 2) * 16384;
    us* cb = cf + 16384;
#pragma unroll
    for (int m = 0; m < 2; ++m)
#pragma unroll
      for (int n = 0; n < 4; ++n) {
        int dv = wr * 32 + m * 16 + fr, dk = wc * 64 + n * 16 + fq * 4;
        f32x4 v = accF[m][n];
        *(uint2*)(cf + dv * 128 + dk) = make_uint2(pack2(v[0], v[1]), pack2(v[2], v[3]));
        v = accB[m][n];
        *(uint2*)(cb + dv * 128 + dk) = make_uint2(pack2(v[0], v[1]), pack2(v[2], v[3]));
      }
  }
}

DEVI void phase_scan(const Params& p, int g) {
  const int tid = opq(threadIdx.x);
  const int nc = g ? 64 : 32;
  const int nitems = (g ? 4 : 8) * 64;
  for (int item = blockIdx.x; item < nitems; item += gridDim.x) {
    const int slice = item & 7, d = (item >> 3) & 1, h = (item >> 4) & 3, sq = item >> 6;
    const bool nrow = (slice == 0) && (tid < 128);
    float C[4] = {0.f, 0.f, 0.f, 0.f};
    float m = -1e30f, nacc = 0.f;
    const size_t toff = (size_t)slice * 2048 + tid * 4;
    uint2 cl[4];
    float2 gmv[4];
    float nlv[4];
#pragma unroll
    for (int j = 0; j < 4; ++j) {
      int c = d ? nc - 1 - j : j;
      size_t U = (size_t)(((sq * nc + c) * 4 + h) * 2 + d);
      cl[j] = *(const uint2*)(p.states + U * 16384 + toff);
      gmv[j] = *(const float2*)(p.scstate + U * 2);
      nlv[j] = nrow ? p.nstate[U * 128 + tid] : 0.f;
    }
#pragma unroll 1
    for (int cc0 = 0; cc0 < nc; cc0 += 4) {
#pragma unroll
      for (int j = 0; j < 4; ++j) {
        const int cc = cc0 + j;
        const int c = d ? nc - 1 - cc : cc;
        const size_t U = (size_t)(((sq * nc + c) * 4 + h) * 2 + d);
        us* ptr = p.states + U * 16384 + toff;
        const uint2 clv = cl[j];
        const float2 gm = gmv[j];
        const float nl = nlv[j];
        if (cc + 4 < nc) {
          const int c2 = d ? c - 4 : c + 4;
          const size_t U2 = (size_t)(((sq * nc + c2) * 4 + h) * 2 + d);
          cl[j] = *(const uint2*)(p.states + U2 * 16384 + toff);
          gmv[j] = *(const float2*)(p.scstate + U2 * 2);
          nlv[j] = nrow ? p.nstate[U2 * 128 + tid] : 0.f;
        }
        const float gch = gm.x, mloc = gm.y;
        const float mn = fmaxf(gch + m, mloc);
        const float dec = __expf(gch + m - mn), sc = __expf(mloc - mn);
        *(uint2*)ptr = make_uint2(pack2(C[0], C[1]), pack2(C[2], C[3]));
        if (nrow) {
          p.nprev[U * 128 + tid] = nacc;
          nacc = dec * nacc + sc * nl;
        }
        if (slice == 0 && tid == 0) p.mprev[U] = m;
        C[0] = dec * C[0] + sc * bflo(clv.x);
        C[1] = dec * C[1] + sc * bfhi(clv.x);
        C[2] = dec * C[2] + sc * bflo(clv.y);
        C[3] = dec * C[3] + sc * bfhi(clv.y);
        m = mn;
      }
    }
  }
}

DEVI void phase_mlout(const Params& p, int g, char* smem) {
  const int tid = opq(threadIdx.x), lane = tid & 63, wid = tid >> 6, fr = lane & 15, fq = lane >> 4;
  us* Pl = (us*)smem;
  us* VT = (us*)(smem + 34816);
  char* stage = smem + 34816;
  float* vec = (float*)(smem + 34816 + 65536);
  float* bv = vec; float* Mv = vec + 256; float* einv = vec + 512; float* emt = vec + 768; float* qn = vec + 1024;
  float* tmp = vec + 1280;
  for (int unit = blockIdx.x; unit < 1024; unit += gridDim.x) {
    const int cl = unit >> 2, h = unit & 3, t0 = cl * 128;
    __syncthreads();
#pragma unroll
    for (int d = 0; d < 2; ++d) {
      int l = d ? 127 - (tid & 127) : (tid & 127);
      const float* gr = p.gates + (size_t)(t0 + l) * 16;
      float ig = gr[d * 4 + h], fg = gr[8 + d * 4 + h];
      float a = scan128_sum(logsigf_(fg), tmp);
      float b = ig - a;
      float pm = scan128_max(b, tmp);
      float mp = p.mprev[unit * 2 + d];
      float M = fmaxf(mp, pm);
      if (tid < 128) {
        bv[d * 128 + l] = b; Mv[d * 128 + l] = M; einv[d * 128 + l] = __expf(mp - M); emt[d * 128 + l] = __expf(-(a + M));
      }
    }
    if (tid < 256) {
      int d = tid >> 7, t = tid & 127;
      const us* qr = p.z + (size_t)(t0 + t) * ZW + 1536 + h * 128;
      const float* nr = p.nprev + (size_t)(unit * 2 + d) * 128;
      float s = 0.f;
#pragma unroll 8
      for (int i = 0; i < 16; ++i) {
        uint4 q = *(const uint4*)(qr + i * 8);
        float4 n0 = *(const float4*)(nr + i * 8), n1 = *(const float4*)(nr + i * 8 + 4);
        s += bflo(q.x) * n0.x + bfhi(q.x) * n0.y + bflo(q.y) * n0.z + bfhi(q.y) * n0.w + bflo(q.z) * n1.x + bfhi(q.z) * n1.y +
             bflo(q.w) * n1.z + bfhi(q.w) * n1.w;
      }
      qn[d * 128 + t] = s * QS;
    }
    __syncthreads();
    const us* zq = p.z + (size_t)t0 * ZW + 1536 + h * 128;
    const us* zk = p.z + (size_t)t0 * ZW + 2048 + h * 128;
    f32x4 sacc[1][8], pb[1][8];
    zero_acc(sacc);
    gemm_core<128, 128, 8, 1, false>(zq, ZW, zk, ZW, 128, stage, sacc);
    const int t = wid * 16 + fr;
    float cF, cB;
    {
      float Mf = Mv[t], Mb = Mv[128 + t];
      float rf = 0.f, rb = 0.f;
#pragma unroll
      for (int n = 0; n < 8; ++n)
#pragma unroll
        for (int j = 0; j < 4; ++j) {
          int s = n * 16 + fq * 4 + j;
          float sv = sacc[0][n][j] * QS;
          float pf = 0.f, pbv = 0.f;
          if (n <= wid) pf = (s <= t) ? sv * __expf(bv[s] - Mf) : 0.f;
          if (n >= wid) pbv = (s >= t) ? sv * __expf(bv[128 + s] - Mb) : 0.f;
          rf += pf; rb += pbv;
          sacc[0][n][j] = pf; pb[0][n][j] = pbv;
          if (j == 3) __builtin_amdgcn_sched_barrier(0);
        }
      rf += __shfl_xor(rf, 16); rf += __shfl_xor(rf, 32);
      rb += __shfl_xor(rb, 16); rb += __shfl_xor(rb, 32);
      float denf = rf + einv[t] * qn[t], denb = rb + einv[128 + t] * qn[128 + t];
      float invf = 1.f / fmaxf(fabsf(denf), emt[t]), invb = 1.f / fmaxf(fabsf(denb), emt[128 + t]);
      cF = einv[t] * QS * invf; cB = einv[128 + t] * QS * invb;
#pragma unroll
      for (int n = 0; n < 8; ++n) {
        f32x4 a = sacc[0][n], b = pb[0][n];
        *(uint2*)(Pl + t * 136 + n * 16 + fq * 4) = make_uint2(pack2(a[0] * invf + b[0] * invb, a[1] * invf + b[1] * invb),
                                                                pack2(a[2] * invf + b[2] * invb, a[3] * invf + b[3] * invb));
        __builtin_amdgcn_sched_barrier(0);
      }
    }
    f32x4 acc[1][8];
    zero_acc(sacc);
    gemm_core<128, 128, 8, 1, false>(zq, ZW, p.states + (size_t)(unit * 2) * 16384, 128, 128, stage, sacc);
#pragma unroll
    for (int n = 0; n < 8; ++n) acc[0][n] = sacc[0][n] * cF;
    zero_acc(sacc);
    gemm_core<128, 128, 8, 1, false>(zq, ZW, p.states + (size_t)(unit * 2 + 1) * 16384, 128, 128, stage, sacc);
#pragma unroll
    for (int n = 0; n < 8; ++n) acc[0][n] += sacc[0][n] * cB;
    for (int idx = tid; idx < 2048; idx += NT) {
      int l = idx & 127, c8 = idx >> 7;
      uint4 vv = *(const uint4*)(p.z + (size_t)(t0 + l) * ZW + 2560 + h * 128 + c8 * 8);
      const u32* vw = (const u32*)&vv;
#pragma unroll
      for (int i = 0; i < 4; ++i) {
        VT[(c8 * 8 + 2 * i) * 136 + l] = (us)(vw[i] & 0xffffu);
        VT[(c8 * 8 + 2 * i + 1) * 136 + l] = (us)(vw[i] >> 16);
      }
    }
    __syncthreads();
    mma_lds<128, 8, 1>(Pl, 136, VT, 136, 128, acc);
    {
      float ss = 0.f;
#pragma unroll
      for (int n = 0; n < 8; ++n)
#pragma unroll
        for (int j = 0; j < 4; ++j) ss += acc[0][n][j] * acc[0][n][j];
      ss += __shfl_xor(ss, 16); ss += __shfl_xor(ss, 32);
      float rs = rsqrtf(ss * (1.f / 128.f) + EPS);
#pragma unroll
      for (int n = 0; n < 8; ++n) {
        int col = h * 128 + n * 16 + fq * 4;
        uint2 ov = *(const uint2*)(p.z + (size_t)(t0 + t) * ZW + 3072 + col);
        float4 w4 = *(const float4*)(p.mlstm_norm_w + col);
        f32x4 v = acc[0][n];
        float y0 = v[0] * rs * w4.x * sigmoidf_(bflo(ov.x)), y1 = v[1] * rs * w4.y * sigmoidf_(bfhi(ov.x));
        float y2 = v[2] * rs * w4.z * sigmoidf_(bflo(ov.y)), y3 = v[3] * rs * w4.w * sigmoidf_(bfhi(ov.y));
        *(uint2*)(p.buf67 + (size_t)(t0 + t) * 1024 + 512 + col) = make_uint2(pack2(y0, y1), pack2(y2, y3));
      }
    }
  }
}

template <bool XF32>
DEVI void phase_resid_gemm(const Params& p, int g, const us* A, const us* Wt, const float* xold, float* ss, us* xout, int ldo, char* smem) {
  g8::EpiResid<XF32> E{xold, p.xb, xout, ldo, ss + g * TG};
  g8::gemm_phase((G8_LAS unsigned char*)smem, A, 1024, Wt, TG, 1024, 1024, E);
}

DEVI void phase_proj(const Params& p, int g, const us* A, int lda, const us* Wt, int N, const float* ss, us* O, char* smem) {
  g8::EpiScaleBf16 E{O, N, ss + g * TG};
  g8::gemm_phase((G8_LAS unsigned char*)smem, A, lda, Wt, TG, N, 1024, E);
}

DEVI void phase_xattn(const Params& p, int g, char* smem) {
  const int tid = opq(threadIdx.x), lane = tid & 63, wid = tid >> 6, fr = lane & 15, fq = lane >> 4;
  us* Pl = (us*)smem;
  char* stage2 = smem + 67584;
  for (int unit = blockIdx.x; unit < 1024; unit += gridDim.x) {
    const int tile = unit >> 2, h = unit & 3, t0 = tile * 128;
    const int mb = g ? 2048 + (t0 >> 13) * 256 : (t0 >> 12) * 256;
    __syncthreads();
    f32x4 sacc[1][16];
    zero_acc(sacc);
    gemm_core<128, 256, 8, 1, false>(p.Qb + (size_t)t0 * 1024 + h * 256, 1024, p.Kmem + (size_t)mb * 1024 + h * 256, 1024, 256, smem, sacc);
    const int t = wid * 16 + fr;
    float linv;
    {
      float mx = -3.0e38f;
#pragma unroll
      for (int n = 0; n < 16; ++n)
#pragma unroll
        for (int j = 0; j < 4; ++j) mx = fmaxf(mx, sacc[0][n][j]);
      mx = fmaxf(mx, __shfl_xor(mx, 16)); mx = fmaxf(mx, __shfl_xor(mx, 32));
      float sum = 0.f;
#pragma unroll
      for (int n = 0; n < 16; ++n) {
        f32x4 a;
#pragma unroll
        for (int j = 0; j < 4; ++j) { a[j] = __expf((sacc[0][n][j] - mx) * 0.0625f); sum += a[j]; }
        *(uint2*)(Pl + t * 264 + n * 16 + fq * 4) = make_uint2(pack2(a[0], a[1]), pack2(a[2], a[3]));
      }
      sum += __shfl_xor(sum, 16); sum += __shfl_xor(sum, 32);
      linv = 1.f / sum;
    }
    zero_acc(sacc);
    gemm_core<128, 256, 8, 1, true>(Pl, 264, p.VmemT + (size_t)(h * 256) * 3072 + mb, 3072, 256, stage2, sacc);
#pragma unroll
    for (int n = 0; n < 16; ++n) {
      f32x4 a = sacc[0][n] * linv;
      *(uint2*)(p.Ob + (size_t)(t0 + t) * 1024 + h * 256 + n * 16 + fq * 4) = make_uint2(pack2(a[0], a[1]), pack2(a[2], a[3]));
    }
  }
}

DEVI void top16_of_128(const f32x4 (&sc)[8], int fq, u32 (&sel)[16]) {
  u32 v[32];
#pragma unroll
  for (int n = 0; n < 8; ++n)
#pragma unroll
    for (int j = 0; j < 4; ++j) {
      int key = n * 16 + fq * 4 + j;
      v[n * 4 + j] = ((ordf(sc[n][j]) >> 1) & ~127u) | (u32)(127 - key);
    }
  u32 prev = 0x80000000u;
#pragma unroll
  for (int k = 0; k < 16; ++k) {
    u32 base = prev - 1u;
    u32 d = base - v[0];
#pragma unroll
    for (int i = 1; i < 32; ++i) d = min(d, base - v[i]);
    d = min(d, (u32)__shfl_xor((int)d, 16));
    d = min(d, (u32)__shfl_xor((int)d, 32));
    prev = base - d;
    sel[k] = prev;
  }
}

DEVI void phase_topk(const Params& p, int g, char* smem) {
  const int tid = opq(threadIdx.x), lane = tid & 63, wid = tid >> 6, fr = lane & 15, fq = lane >> 4;
  int* il = (int*)(smem + 65536);
  bool pre = false;
  for (int unit = blockIdx.x; unit < 2048; unit += gridDim.x) {
    const int tile = unit >> 3, h = unit & 7, t0 = tile * 128;
    u32 sel[2][16];
    const us* a0p = p.pq + (size_t)t0 * 2048 + h * 256;
    {
      f32x4 sc[1][8];
      zero_acc(sc);
      if (pre) gemm_core<128, 128, 8, 1, false, true>(a0p, 2048, p.keys1b + (size_t)h * 16384, 128, 128, smem, sc);
      else gemm_core<128, 128, 8, 1, false, false>(a0p, 2048, p.keys1b + (size_t)h * 16384, 128, 128, smem, sc);
      gemm_issue0<128, 128, false>(a0p + 128, 2048, p.keys2b + (size_t)h * 16384, 128, smem);
      top16_of_128(sc[0], fq, sel[0]);
    }
    {
      f32x4 sc[1][8];
      zero_acc(sc);
      gemm_core<128, 128, 8, 1, false, true>(a0p + 128, 2048, p.keys2b + (size_t)h * 16384, 128, 128, smem, sc);
      const int un = unit + gridDim.x;
      pre = un < 2048;
      if (pre) gemm_issue0<128, 128, false>(p.pq + (size_t)(un >> 3) * 128 * 2048 + (un & 7) * 256, 2048, p.keys1b + (size_t)(un & 7) * 16384, 128, smem);
      top16_of_128(sc[0], fq, sel[1]);
    }
    {
      const int t = wid * 16 + fr;
      float v1[16], v2[16];
#pragma unroll
      for (int k = 0; k < 16; ++k) {
        v1[k] = unordf((sel[0][k] & ~127u) << 1);
        v2[k] = unordf((sel[1][k] & ~127u) << 1);
        il[(t * 2 + 0) * 16 + k] = 127 - (int)(sel[0][k] & 127u);
        il[(t * 2 + 1) * 16 + k] = 127 - (int)(sel[1][k] & 127u);
      }
      u32 c[50];
      {
        int ci = 0;
#pragma unroll
        for (int a = 0; a < 16; ++a)
#pragma unroll
          for (int b = 0; b < 16; ++b)
            if ((a + 1) * (b + 1) <= 16) { c[ci] = ((ordf(v1[a] + v2[b]) >> 1) & ~255u) | (u32)(255 - (a * 16 + b)); ++ci; }
      }
      u32 prev = 0x80000000u;
      float sv[16];
      int se[16];
#pragma unroll
      for (int k = 0; k < 16; ++k) {
        u32 base = prev - 1u;
        u32 d = base - c[0];
#pragma unroll
        for (int i = 1; i < 50; ++i) d = min(d, base - c[i]);
        prev = base - d;
        int code = 255 - (int)(prev & 255u);
        sv[k] = unordf((prev & ~255u) << 1);
        se[k] = il[(t * 2 + 0) * 16 + (code >> 4)] * 128 + il[(t * 2 + 1) * 16 + (code & 15)];
      }
      const float mxv = sv[0];
      float tot = 0.f;
#pragma unroll
      for (int k = 0; k < 16; ++k) { sv[k] = __expf(sv[k] - mxv); tot += sv[k]; }
      const float inv = 1.f / tot;
      if (fq == 0) {
        size_t ob = (size_t)(t0 + t) * 128 + h * 16;
#pragma unroll
        for (int k = 0; k < 16; k += 4) {
          *(int4*)(p.eidx + ob + k) = make_int4(se[k], se[k + 1], se[k + 2], se[k + 3]);
          *(float4*)(p.gatew + ob + k) = make_float4(sv[k] * inv, sv[k + 1] * inv, sv[k + 2] * inv, sv[k + 3] * inv);
        }
      }
    }
  }
}

DEVI void phase_gather(const Params& p, int g, char* smem) {
  const int tid_ = opq(threadIdx.x);
  const int lane = tid_ & 63, wid = tid_ >> 6, r = lane & 15, q = lane >> 4;
  const int hh = lane >> 5, l = lane & 31;
  const int cbase = l * 32 + hh * 16;
  char* wbase = smem + wid * 18688;
  char* ubuf = wbase;
  us* hrow = (us*)(wbase + 12416);
  float* wl = (float*)(wbase + 12416 + 2048);
  int* el = (int*)(wbase + 12416 + 2560);
  const unsigned char* U8 = (const unsigned char*)p.Ub;
  const unsigned char* V6 = (const unsigned char*)p.Vb;
  for (int tok = blockIdx.x * 8 + wid; tok < TG; tok += gridDim.x * 8) {
    const size_t gt = (size_t)g * TG + tok;
    float* xr = p.out + gt * 1024 + cbase;
    float4 xa[4];
    {
      const uint4* xbr = (const uint4*)((const us*)(p.out + gt * 1024) + cbase);
      uint4 x0 = xbr[0], x1 = xbr[1];
      xa[0] = make_float4(bflo(x0.x), bfhi(x0.x), bflo(x0.y), bfhi(x0.y));
      xa[1] = make_float4(bflo(x0.z), bfhi(x0.z), bflo(x0.w), bfhi(x0.w));
      xa[2] = make_float4(bflo(x1.x), bfhi(x1.x), bflo(x1.y), bfhi(x1.y));
      xa[3] = make_float4(bflo(x1.z), bfhi(x1.z), bflo(x1.w), bfhi(x1.w));
    }
    const float rs2 = rsqrtf(p.ss2[gt] * (1.f / 1024.f) + EPS);
    {
      const float* w = p.norm_ffn_w + cbase;
      asm volatile("" : "+v"(w));
      u32 hw[8];
#pragma unroll
      for (int i = 0; i < 4; ++i) {
        float4 w4 = *(const float4*)(w + i * 4);
        hw[2 * i] = pack2(xa[i].x * rs2 * w4.x, xa[i].y * rs2 * w4.y);
        hw[2 * i + 1] = pack2(xa[i].z * rs2 * w4.z, xa[i].w * rs2 * w4.w);
      }
      *(uint4*)(hrow + cbase) = make_uint4(hw[0], hw[1], hw[2], hw[3]);
      *(uint4*)(hrow + cbase + 8) = make_uint4(hw[4], hw[5], hw[6], hw[7]);
    }
    el[lane] = p.eidx[(size_t)tok * 128 + lane];
    el[64 + lane] = p.eidx[(size_t)tok * 128 + 64 + lane];
    __builtin_amdgcn_wave_barrier();
    asm volatile("s_waitcnt vmcnt(0) lgkmcnt(0)" ::: "memory");
    float o[32];
#pragma unroll
    for (int i = 0; i < 32; ++i) o[i] = 0.f;
#pragma unroll 1
    for (int gi = 0; gi < 9; ++gi) {
      uint4 vv[4];
      if (gi > 0) {
#pragma unroll
        for (int k = 0; k < 4; ++k) {
          u32 e = (u32)el[(gi - 1) * 16 + 2 * k + hh];
          vv[k] = *(const uint4*)(V6 + (e * 512u + (u32)l * 16u));
        }
      }
      if (gi < 8) {
#pragma unroll
        for (int j = 0; j < 4; ++j) {
          const u32 e0 = (u32)el[gi * 16 + 4 * j], e1 = (u32)el[gi * 16 + 4 * j + 1], e2 = (u32)el[gi * 16 + 4 * j + 2], e3 = (u32)el[gi * 16 + 4 * j + 3];
#pragma unroll
          for (int t = 0; t < 3; ++t) {
            const int C = t * 64 + lane;
            const int i = (C >= 144) ? 3 : (C >= 96) ? 2 : (C >= 48) ? 1 : 0;
            int cs = C - i * 48 - 4 * i;
            cs = cs < 0 ? cs + 48 : cs;
            const u32 e = (i == 0) ? e0 : (i == 1) ? e1 : (i == 2) ? e2 : e3;
            __builtin_amdgcn_global_load_lds((const u32*)(U8 + (e * 768u + (u32)(cs << 4))), (u32*)(ubuf + j * 3088 + t * 1024), 16, 0, 0);
          }
        }
      }
      if (gi > 0) {
        if (gi < 8) asm volatile("s_waitcnt vmcnt(12)" ::: "memory");
        else asm volatile("s_waitcnt vmcnt(0)" ::: "memory");
#pragma unroll
        for (int k = 0; k < 4; ++k) {
          const float wk = wl[(gi - 1) * 16 + 2 * k + hh];
          const u32 vw[4] = {vv[k].x, vv[k].y, vv[k].z, vv[k].w};
#pragma unroll
          for (int d = 0; d < 4; ++d) {
            v2f r0 = __builtin_amdgcn_cvt_scalef32_pk_f32_fp4(vw[d], 1.0f, 0);
            v2f r1 = __builtin_amdgcn_cvt_scalef32_pk_f32_fp4(vw[d], 1.0f, 1);
            v2f r2 = __builtin_amdgcn_cvt_scalef32_pk_f32_fp4(vw[d], 1.0f, 2);
            v2f r3 = __builtin_amdgcn_cvt_scalef32_pk_f32_fp4(vw[d], 1.0f, 3);
            o[d * 8 + 0] += wk * r0[0]; o[d * 8 + 1] += wk * r0[1]; o[d * 8 + 2] += wk * r1[0]; o[d * 8 + 3] += wk * r1[1];
            o[d * 8 + 4] += wk * r2[0]; o[d * 8 + 5] += wk * r2[1]; o[d * 8 + 6] += wk * r3[0]; o[d * 8 + 7] += wk * r3[1];
          }
        }
#pragma unroll
        for (int k = 0; k < 4; ++k) {
          u32 e = (u32)el[(gi - 1) * 16 + 8 + 2 * k + hh];
          vv[k] = *(const uint4*)(V6 + (e * 512u + (u32)l * 16u));
        }
      }
      asm volatile("s_waitcnt vmcnt(0)" ::: "memory");
      if (gi > 0) {
#pragma unroll
        for (int k = 0; k < 4; ++k) {
          const float wk = wl[(gi - 1) * 16 + 8 + 2 * k + hh];
          const u32 vw[4] = {vv[k].x, vv[k].y, vv[k].z, vv[k].w};
#pragma unroll
          for (int d = 0; d < 4; ++d) {
            v2f r0 = __builtin_amdgcn_cvt_scalef32_pk_f32_fp4(vw[d], 1.0f, 0);
            v2f r1 = __builtin_amdgcn_cvt_scalef32_pk_f32_fp4(vw[d], 1.0f, 1);
            v2f r2 = __builtin_amdgcn_cvt_scalef32_pk_f32_fp4(vw[d], 1.0f, 2);
            v2f r3 = __builtin_amdgcn_cvt_scalef32_pk_f32_fp4(vw[d], 1.0f, 3);
            o[d * 8 + 0] += wk * r0[0]; o[d * 8 + 1] += wk * r0[1]; o[d * 8 + 2] += wk * r1[0]; o[d * 8 + 3] += wk * r1[1];
            o[d * 8 + 4] += wk * r2[0]; o[d * 8 + 5] += wk * r2[1]; o[d * 8 + 6] += wk * r3[0]; o[d * 8 + 7] += wk * r3[1];
          }
        }
      }
      if (gi < 8) {
        f32x4 acc = {0.f, 0.f, 0.f, 0.f};
#pragma unroll
        for (int s2 = 0; s2 < 8; ++s2) {
          const char* rowb = ubuf + (r >> 2) * 3088 + (r & 3) * 768;
          uint2 apc[3];
#pragma unroll
          for (int pc = 0; pc < 3; ++pc) {
            const int bo = s2 * 96 + q * 24 + pc * 8;
            int cp = (bo >> 4) + 4 * (r & 3);
            cp = cp >= 48 ? cp - 48 : cp;
            apc[pc] = *(const uint2*)(rowb + cp * 16 + (bo & 8));
          }
          uint2 a0 = apc[0], a1 = apc[1], a2 = apc[2];
          v6i pk = {(int)a0.x, (int)a0.y, (int)a1.x, (int)a1.y, (int)a2.x, (int)a2.y};
          const v32s ub = __builtin_bit_cast(v32s, __builtin_amdgcn_cvt_scalef32_pk32_bf16_fp6(pk, 1.0f));
          const bf16x8* bp = (const bf16x8*)(hrow + s2 * 128 + q * 32);
#pragma unroll
          for (int g2 = 0; g2 < 4; ++g2) {
            bf16x8 a8 = {ub[8 * g2], ub[8 * g2 + 1], ub[8 * g2 + 2], ub[8 * g2 + 3], ub[8 * g2 + 4], ub[8 * g2 + 5], ub[8 * g2 + 6], ub[8 * g2 + 7]};
            acc = __builtin_amdgcn_mfma_f32_16x16x32_bf16(a8, bp[g2], acc, 0, 0, 0);
          }
        }
        if (r == 0) {
          int idx = gi * 16 + q * 4;
          float4 gw = *(const float4*)(p.gatew + (size_t)tok * 128 + idx);
          *(float4*)(wl + idx) = make_float4(gw.x * gelu_tanh(acc[0] * 0.015625f), gw.y * gelu_tanh(acc[1] * 0.015625f),
                                             gw.z * gelu_tanh(acc[2] * 0.015625f), gw.w * gelu_tanh(acc[3] * 0.015625f));
        }
        asm volatile("s_waitcnt lgkmcnt(0)" ::: "memory");
      }
    }
#pragma unroll
    for (int i = 0; i < 32; ++i) o[i] += __shfl_xor(o[i], 32);
    float ss = 0.f;
#pragma unroll
    for (int i = 0; i < 4; ++i) {
      const float o0 = hh ? o[16 + i * 4] : o[i * 4], o1 = hh ? o[16 + i * 4 + 1] : o[i * 4 + 1];
      const float o2 = hh ? o[16 + i * 4 + 2] : o[i * 4 + 2], o3 = hh ? o[16 + i * 4 + 3] : o[i * 4 + 3];
      xa[i].x += o0 * 0.0625f; xa[i].y += o1 * 0.0625f; xa[i].z += o2 * 0.0625f; xa[i].w += o3 * 0.0625f;
      ss += xa[i].x * xa[i].x + xa[i].y * xa[i].y + xa[i].z * xa[i].z + xa[i].w * xa[i].w;
    }
    ss = wave_sum(ss);
    const float rf = rsqrtf(ss * (1.f / 1024.f) + EPS);
    const float* wf = p.norm_final_w + cbase;
    asm volatile("" : "+v"(wf));
#pragma unroll
    for (int i = 0; i < 4; ++i) {
      float4 w4 = *(const float4*)(wf + i * 4);
      *(float4*)(xr + i * 4) = make_float4(xa[i].x * rf * w4.x, xa[i].y * rf * w4.y, xa[i].z * rf * w4.z, xa[i].w * rf * w4.w);
    }
    __builtin_amdgcn_wave_barrier();
    asm volatile("s_waitcnt lgkmcnt(0)" ::: "memory");
  }
}

DEVI void phase_final_simple(const Params& p, int g) {
  const int gtid = blockIdx.x * NT + opq(threadIdx.x), gsz = gridDim.x * NT;
  const int gw = gtid >> 6, nw = gsz >> 6, lane = gtid & 63;
  for (int r = gw; r < TG; r += nw) {
    float* xr = p.out + ((size_t)g * TG + r) * 1024;
    float4 v[4];
    float ss = 0.f;
#pragma unroll
    for (int i = 0; i < 4; ++i) {
      v[i] = ((const float4*)xr)[i * 64 + lane];
      ss += v[i].x * v[i].x + v[i].y * v[i].y + v[i].z * v[i].z + v[i].w * v[i].w;
    }
    ss = wave_sum(ss);
    float rs = rsqrtf(ss * (1.f / 1024.f) + EPS);
#pragma unroll
    for (int i = 0; i < 4; ++i) {
      float4 w = ((const float4*)p.norm_final_w)[i * 64 + lane];
      ((float4*)xr)[i * 64 + lane] = make_float4(v[i].x * rs * w.x, v[i].y * rs * w.y, v[i].z * rs * w.z, v[i].w * rs * w.w);
    }
  }
}


#define XB_TMO      128
#define XB_XCNT(j)  (256  + 64 * (j))
#define XB_XSUB(j)  (1280 + 64 * (j))
#define XB_XGEN(j)  (2304 + 64 * (j))
#define XB_TOP      3328
#define XB_TOPGEN   3392
#define XCD_BAR_WORDS 3456
#define XB_SPIN_CAP (1u << 20)
#define LAS __attribute__((address_space(3)))
DEVI unsigned xb_ld(unsigned* p) { return __hip_atomic_load(p, __ATOMIC_RELAXED, __HIP_MEMORY_SCOPE_AGENT); }
DEVI unsigned xb_add(unsigned* p, unsigned v) { return __hip_atomic_fetch_add(p, v, __ATOMIC_RELAXED, __HIP_MEMORY_SCOPE_AGENT); }
DEVI unsigned xb_xcc_id() { return (unsigned)__builtin_amdgcn_s_getreg((3 << 11) | 20) & 0xFu; }
#define XB_SPIN(cond, bar) do { unsigned _sp = 0; while (cond) { __builtin_amdgcn_s_sleep(1); \
    if ((++_sp & 255u) == 0u) { if (xb_ld(&(bar)[XB_TMO])) break; if (_sp > XB_SPIN_CAP) { atomicAdd(&(bar)[XB_TMO], 1u); break; } } } } while (0)
struct XcdBarrier { unsigned* bar; unsigned x; volatile LAS unsigned* st; };
DEVI XcdBarrier xcd_barrier_post(unsigned* bar, volatile LAS unsigned* st) {
  XcdBarrier b; b.bar = bar; b.x = xb_xcc_id(); b.st = st;
  if (threadIdx.x == 0) (void)xb_add(&bar[XB_XCNT(b.x)], 1u);
  return b;
}
DEVI void xcd_barrier_complete(unsigned* bar, unsigned x, unsigned& nloc, unsigned& nx) {
  const unsigned G = gridDim.x * gridDim.y * gridDim.z;
  unsigned sum, cnt, mine, sp = 0u;
  for (;;) {
    sum = 0u; cnt = 0u; mine = 0u;
#pragma unroll
    for (unsigned j = 0; j < 16; ++j) { const unsigned c = xb_ld(&bar[XB_XCNT(j)]); sum += c; cnt += (c > 0u) ? 1u : 0u; mine = (j == x) ? c : mine; }
    if (sum == G) break;
    __builtin_amdgcn_s_sleep(1);
    if ((++sp & 255u) == 0u) { if (xb_ld(&bar[XB_TMO])) break; if (sp > XB_SPIN_CAP) { atomicAdd(&bar[XB_TMO], 1u); break; } }
  }
  nloc = mine > 0u ? mine : 1u; nx = cnt > 0u ? cnt : 1u;
}
DEVI void xcd_barrier(const XcdBarrier& b) {
  asm volatile("s_waitcnt vmcnt(0)" ::: "memory");
  __syncthreads();
  if (threadIdx.x == 0) {
    unsigned* bar = b.bar;
    __builtin_amdgcn_s_waitcnt(0);
    unsigned nloc = b.st[0], nx = b.st[1];
    if (nloc == 0u) { xcd_barrier_complete(bar, b.x, nloc, nx); b.st[0] = nloc; b.st[1] = nx; }
    const unsigned old = xb_add(&bar[XB_XSUB(b.x)], 1u);
    const unsigned gen = old / nloc;
    if (old + 1u == (gen + 1u) * nloc) {
      __builtin_amdgcn_fence(__ATOMIC_RELEASE, "agent");
      asm volatile("s_waitcnt vmcnt(0)" ::: "memory");
      const unsigned og = xb_add(&bar[XB_TOP], 1u);
      const unsigned tg = og / nx;
      if (og + 1u == (tg + 1u) * nx) xb_add(&bar[XB_TOPGEN], 1u);
      else XB_SPIN(xb_ld(&bar[XB_TOPGEN]) == tg, bar);
      __builtin_amdgcn_fence(__ATOMIC_ACQUIRE, "agent");
      xb_add(&bar[XB_XGEN(b.x)], 1u);
      asm volatile("s_waitcnt vmcnt(0)" ::: "memory");
    } else {
      XB_SPIN(xb_ld(&bar[XB_XGEN(b.x)]) == gen, bar);
      __builtin_amdgcn_fence(__ATOMIC_ACQUIRE, "agent");
      asm volatile("s_waitcnt vmcnt(0)" ::: "memory");
    }
  }
  __syncthreads();
}

__global__ void __launch_bounds__(NT, 2) mega(Params p, int pb, int pe) {
  extern __shared__ __attribute__((aligned(16))) char smem[];
  cg::grid_group grid = cg::this_grid();
  volatile LAS unsigned* xst = (volatile LAS unsigned*)(smem + LDS_BYTES - 16);
  if (threadIdx.x == 0) { xst[0] = 0u; xst[1] = 0u; }
  __syncthreads();
  XcdBarrier xb;
  xb.bar = p.bar; xb.x = xb_xcc_id(); xb.st = xst;
  int ph = 0;
#define PHASE(...)                                               \
  {                                                              \
    if (ph >= pb && ph < pe) {                                   \
      __VA_ARGS__;                                               \
      if (ph + 1 < pe) { if (ph == 0) { grid.sync(); xb = xcd_barrier_post(p.bar, xst); } else { if (USE_XCD_BAR) xcd_barrier(xb); else grid.sync(); } } \
    }                                                            \
    ++ph;                                                        \
  }
  PHASE(if (blockIdx.x == 0) { for (int i = threadIdx.x; i < XCD_BAR_WORDS; i += NT) p.bar[i] = 0u; }
        phase_prep(p); phase_hb(p, 0); if (PROBE == 5) { phase_prep(p); } if (PROBE == 6) { phase_hb(p, 0); phase_hb(p, 0); })
  PHASE(phase_inproj(p, 0, smem); if (PROBE == 1) phase_inproj(p, 0, smem);)
#pragma unroll
  for (int g = 0; g < 2; ++g) {
    const float* xg = g ? p.x_sample : p.x_prompt;
    PHASE(conv_part(p, g); phase_local(p, g, smem);)
    PHASE(phase_scan(p, g);)
#if PROBE == 2
    PHASE(conv_part(p, g); phase_local(p, g, smem);)
    PHASE(phase_scan(p, g);)
#endif
    PHASE(phase_mlout(p, g, smem); if (PROBE == 2) phase_mlout(p, g, smem);)
    PHASE(phase_resid_gemm<true>(p, g, p.buf67, p.Wt_out, xg, p.ss1, p.xb, 1024, smem); if (PROBE == 1) phase_resid_gemm<true>(p, g, p.buf67, p.Wt_out, xg, p.gatew, p.xb, 1024, smem);)
    PHASE(phase_proj(p, g, p.xb, 1024, p.Wt_q, 1024, p.ss1, p.Qb, smem); if (g == 0) phase_hb(p, 1);)
    PHASE(phase_xattn(p, g, smem); if (PROBE == 3) phase_xattn(p, g, smem);)
    PHASE(phase_resid_gemm<false>(p, g, p.Ob, p.Wt_o, nullptr, p.ss2, (us*)(p.out + (size_t)g * TG * 1024), 2048, smem);)
    PHASE(phase_proj(p, g, (const us*)(p.out + (size_t)g * TG * 1024), 2048, p.Wt_pq, 2048, p.ss2, p.pq, smem);)
    PHASE(phase_topk(p, g, smem); if (PROBE == 3) phase_topk(p, g, smem);)
    PHASE(phase_gather(p, g, smem); if (g == 0) { __syncthreads(); phase_inproj(p, 1, smem); if (PROBE == 1) phase_inproj(p, 1, smem); })
  }
}

static int count_phases() { return 2 + 2 * (10 + (PROBE == 2 ? 2 : 0)); }

extern "C" void kernel_launch(void* const* d_in, const int* in_sizes, int n_in, void* d_out, int out_size, void* d_ws,
                              size_t ws_size, hipStream_t stream) {
  static int grid_blocks = 0;
  if (!grid_blocks) {
    hipFuncSetAttribute((const void*)mega, hipFuncAttributeMaxDynamicSharedMemorySize, LDS_BYTES);
    int dev = 0, cus = 0, per_cu = 0;
    hipGetDevice(&dev);
    hipDeviceGetAttribute(&cus, hipDeviceAttributeMultiprocessorCount, dev);
    hipOccupancyMaxActiveBlocksPerMultiprocessor(&per_cu, mega, NT, LDS_BYTES);
    if (per_cu < 1) per_cu = 1;
    if (per_cu > 1) per_cu = 1;
    grid_blocks = cus * per_cu;
  }
  Params p{};
  const float* const* in = (const float* const*)d_in;
  p.x_prompt = in[0]; p.x_sample = in[1]; p.mem_prompt = in[2]; p.mem_sample = in[3]; p.norm_mix_w = in[4]; p.w_in = in[5];
  p.gate_b = in[6]; p.conv_w = in[7]; p.conv_b = in[8]; p.mlstm_norm_w = in[9]; p.w_out = in[10]; p.norm_xattn_w = in[11];
  p.norm_mem_w = in[12]; p.xa_wq = in[13]; p.xa_wk = in[14]; p.xa_wv = in[15]; p.xa_wo = in[16]; p.norm_ffn_w = in[17];
  p.peer_wq = in[18]; p.peer_keys1 = in[19]; p.peer_keys2 = in[20]; p.peer_u = in[21]; p.peer_v = in[22]; p.norm_final_w = in[23];
  p.out = (float*)d_out;
  char* w = (char*)d_ws;
  size_t off = 0;
  auto take = [&](size_t bytes) { char* r = w + off; off += (bytes + 255) & ~(size_t)255; return r; };
  p.Wt_in = (us*)take((size_t)NIN_PAD * 1024 * 2);
  p.Wt_out = (us*)take(1024 * 1024 * 2);
  p.Wt_q = (us*)take(1024 * 1024 * 2);
  p.Wt_k = (us*)take(1024 * 1024 * 2);
  p.Wt_v = (us*)take(1024 * 1024 * 2);
  p.Wt_o = (us*)take(1024 * 1024 * 2);
  p.Wt_pq = (us*)take(2048 * 1024 * 2);
  p.keys1b = (us*)take(8 * 128 * 128 * 2);
  p.keys2b = (us*)take(8 * 128 * 128 * 2);
  p.Ub = (us*)take((size_t)16384 * 1024 * 2);
  p.Vb = (us*)take((size_t)16384 * 1024 * 2);
  p.memn = (us*)take(3072 * 1024 * 2);
  p.Kmem = (us*)take(3072 * 1024 * 2);
  p.VmemT = (us*)take(3072 * 1024 * 2);
  p.ss1 = (float*)take(65536 * 4);
  p.ss2 = (float*)take(65536 * 4);
  char* zbase = take((size_t)TG * ZW * 2);
  p.z = (us*)zbase;
  p.gates = (float*)take((size_t)TG * 16 * 4);
  char* stbase = take((size_t)2048 * 16384 * 2);
  p.states = (us*)stbase;
  p.nstate = (float*)take(2048 * 128 * 4);
  p.nprev = (float*)take(2048 * 128 * 4);
  p.scstate = (float*)take(2048 * 2 * 4);
  p.mprev = (float*)take(2048 * 4);
  p.buf67 = (us*)take((size_t)TG * 1024 * 2);
  p.bar = (unsigned*)take(XCD_BAR_WORDS * 4);
  p.xb = (us*)zbase;
  p.Qb = (us*)(zbase + (size_t)TG * 1024 * 2);
  p.Ob = (us*)(zbase + (size_t)TG * 1024 * 4);
  p.pq = (us*)(zbase + (size_t)TG * 1024 * 2);
  p.eidx = (int*)stbase;
  p.gatew = (float*)(stbase + (size_t)TG * 128 * 4);
  if (off > ws_size) fprintf(stderr, "workspace too small: need %zu have %zu\n", off, ws_size);
  const int nph = count_phases();
#if USE_COOP
  int pb = 0, pe = nph;
  void* args[] = {&p, &pb, &pe};
  hipError_t e = hipLaunchCooperativeKernel((void*)mega, dim3(grid_blocks), dim3(NT), args, LDS_BYTES, stream);
  if (e != hipSuccess) fprintf(stderr, "cooperative launch failed: %s (grid %d)\n", hipGetErrorString(e), grid_blocks);
#else
  for (int i = 0; i < nph; ++i) mega<<<grid_blocks, NT, LDS_BYTES, stream>>>(p, i, i + 1);
#endif
}
```
